# Optimizing an MI355X kernel written in HIP

```python
import jax, jax.numpy as jnp
from jax import lax
import numpy as np

D_MODEL = 2048
BATCH = 4
SEQ = 8192
DEPTH = 1

MLA_HEADS = 8
Q_LORA_RANK = 512
KV_LORA_RANK = 512
QK_NOPE_DIM = 128
QK_ROPE_DIM = 64
V_HEAD_DIM = 128
ROPE_THETA = 10000.0
FOX_HEADS = 8
FOX_HEAD_DIM = 128
MLA_WIDTH = MLA_HEADS * V_HEAD_DIM
FOX_WIDTH = FOX_HEADS * FOX_HEAD_DIM
MIX_WIDTH = MLA_WIDTH + FOX_WIDTH
Q_BLOCK = 128
IN_SPLITS = (Q_LORA_RANK, KV_LORA_RANK, QK_ROPE_DIM, FOX_WIDTH, FOX_WIDTH, FOX_WIDTH, FOX_HEADS)
IN_WIDTH = sum(IN_SPLITS)
N_EXPERTS = 32
TOP_K = 4
D_EXPERT = D_MODEL
SWIGLU_LIMIT = 7.0
SWIGLU_ALPHA = 1.702
EXPERT_BLOCK = 256
NORM_EPS = 1e-5

kernel_name = "hybrid_mla_fox_moe_layer"


def rms_norm(x, g):
    xf = x.astype(jnp.float32)
    y = xf * lax.rsqrt(jnp.mean(xf * xf, axis=-1, keepdims=True) + NORM_EPS)
    return (y * g.astype(jnp.float32)).astype(x.dtype)


def apply_rope(x, pos):
    half = x.shape[-1] // 2
    inv_freq = ROPE_THETA ** (-jnp.arange(half, dtype=jnp.float32) / half)
    ang = pos.astype(jnp.float32)[:, None] * inv_freq[None, :]
    cos = jnp.cos(ang)[None, :, None, :]
    sin = jnp.sin(ang)[None, :, None, :]
    xf = x.astype(jnp.float32)
    x1, x2 = xf[..., :half], xf[..., half:]
    return jnp.concatenate([x1 * cos - x2 * sin, x2 * cos + x1 * sin], axis=-1).astype(x.dtype)


def causal_block_attention(q, k, v, scale, cum_logf=None):
    B, H, S, _ = q.shape
    Dv = v.shape[-1]
    n_blocks = S // Q_BLOCK
    k_pos = jnp.arange(S)

    def one_block(i):
        start = i * Q_BLOCK
        q_blk = lax.dynamic_slice_in_dim(q, start, Q_BLOCK, axis=2)
        s = jnp.einsum('bhqd,bhkd->bhqk', q_blk, k).astype(jnp.float32) * scale
        if cum_logf is not None:
            c_q = lax.dynamic_slice_in_dim(cum_logf, start, Q_BLOCK, axis=2)
            s = s + (c_q[..., :, None] - cum_logf[..., None, :])
        q_pos = start + jnp.arange(Q_BLOCK)
        s = jnp.where(k_pos[None, :] <= q_pos[:, None], s, -jnp.inf)
        p = jax.nn.softmax(s, axis=-1)
        return jnp.einsum('bhqk,bhkd->bhqd', p.astype(v.dtype), v)

    o = lax.map(one_block, jnp.arange(n_blocks))
    return o.transpose(1, 2, 0, 3, 4).reshape(B, H, S, Dv)


def hybrid_mixer(x, pos, g_attn, w_in, g_q_a, w_q_b, g_kv_a, w_kv_b, b_forget,
                 g_mla_out, g_fox_out, w_o):
    B, S, _ = x.shape
    hn = rms_norm(x, g_attn)
    proj = hn @ w_in
    offsets = np.cumsum(np.array(IN_SPLITS))[:-1].tolist()
    q_c, kv_c, k_rope, fq, fk, fv, f_logit = jnp.split(proj, offsets, axis=-1)

    q = (rms_norm(q_c, g_q_a) @ w_q_b).reshape(B, S, MLA_HEADS, QK_NOPE_DIM + QK_ROPE_DIM)
    q_nope, q_rope = q[..., :QK_NOPE_DIM], q[..., QK_NOPE_DIM:]
    kv = (rms_norm(kv_c, g_kv_a) @ w_kv_b).reshape(B, S, MLA_HEADS, QK_NOPE_DIM + V_HEAD_DIM)
    k_nope, v_mla = kv[..., :QK_NOPE_DIM], kv[..., QK_NOPE_DIM:]
    q_rope = apply_rope(q_rope, pos)
    k_rope = apply_rope(k_rope[:, :, None, :], pos)
    q_mla = jnp.concatenate([q_nope, q_rope], axis=-1).transpose(0, 2, 1, 3)
    k_mla = jnp.concatenate(
        [k_nope, jnp.broadcast_to(k_rope, (B, S, MLA_HEADS, QK_ROPE_DIM))], axis=-1
    ).transpose(0, 2, 1, 3)
    o_mla = causal_block_attention(q_mla, k_mla, v_mla.transpose(0, 2, 1, 3),
                                   (QK_NOPE_DIM + QK_ROPE_DIM) ** -0.5)
    o_mla = o_mla.transpose(0, 2, 1, 3).reshape(B, S, MLA_WIDTH)

    def heads(t):
        return t.reshape(B, S, FOX_HEADS, FOX_HEAD_DIM).transpose(0, 2, 1, 3)
    log_f = jax.nn.log_sigmoid(f_logit.astype(jnp.float32) + b_forget.astype(jnp.float32))
    cum_logf = jnp.cumsum(log_f, axis=1).transpose(0, 2, 1)
    o_fox = causal_block_attention(heads(fq), heads(fk), heads(fv), FOX_HEAD_DIM ** -0.5, cum_logf)
    o_fox = o_fox.transpose(0, 2, 1, 3).reshape(B, S, FOX_WIDTH)

    mixed = jnp.concatenate([rms_norm(o_mla, g_mla_out), rms_norm(o_fox, g_fox_out)], axis=-1)
    return mixed @ w_o


def moe_ffn(x, g_ffn, w_router, b_router, w_gate_up, b_gate_up, w_down, b_down):
    B, S, D = x.shape
    T = B * S
    x2d = rms_norm(x, g_ffn).reshape(T, D)
    logits = (x2d @ w_router).astype(jnp.float32) + b_router.astype(jnp.float32)
    top_val, top_idx = lax.top_k(logits, TOP_K)
    gates = jax.nn.softmax(top_val, axis=-1)

    M = T * TOP_K
    e_flat = top_idx.reshape(M)
    tok_flat = jnp.arange(M, dtype=jnp.int32) // TOP_K
    g_flat = gates.reshape(M)
    order = jnp.argsort(e_flat)
    e_s, t_s, g_s = e_flat[order], tok_flat[order], g_flat[order]
    counts = jnp.bincount(e_flat, length=N_EXPERTS)
    padded = (counts + EXPERT_BLOCK - 1) // EXPERT_BLOCK * EXPERT_BLOCK
    start = jnp.cumsum(counts) - counts
    pend = jnp.cumsum(padded)
    pstart = pend - padded
    dest = pstart[e_s] + (jnp.arange(M) - start[e_s])
    n_blocks = -(-(M + N_EXPERTS * (EXPERT_BLOCK - 1)) // EXPERT_BLOCK)
    P = n_blocks * EXPERT_BLOCK
    slot_tok = jnp.full((P,), T, jnp.int32).at[dest].set(t_s)
    slot_gate = jnp.zeros((P,), jnp.float32).at[dest].set(g_s)
    block_expert = jnp.minimum(
        jnp.searchsorted(pend, jnp.arange(n_blocks) * EXPERT_BLOCK, side='right'), N_EXPERTS - 1)
    x_pad = jnp.concatenate([x2d, jnp.zeros((1, D), x2d.dtype)], axis=0)

    def expert_block(args):
        e, toks, g = args
        xb = x_pad[toks]
        gu = xb @ w_gate_up[e] + b_gate_up[e]
        gate, up = gu[:, :D_EXPERT], gu[:, D_EXPERT:]
        gate = jnp.minimum(gate, SWIGLU_LIMIT)
        up = jnp.clip(up, -SWIGLU_LIMIT, SWIGLU_LIMIT)
        hid = gate * jax.nn.sigmoid(SWIGLU_ALPHA * gate) * (up + 1.0)
        return (hid @ w_down[e] + b_down[e]) * g[:, None].astype(xb.dtype)

    y_blocks = lax.map(expert_block, (block_expert,
                                      slot_tok.reshape(n_blocks, EXPERT_BLOCK),
                                      slot_gate.reshape(n_blocks, EXPERT_BLOCK)))
    y = jax.ops.segment_sum(y_blocks.reshape(P, D), slot_tok, num_segments=T + 1)[:T]
    return y.reshape(B, S, D)


def setup_inputs(seed: int = 0) -> dict:
    key = jax.random.key(seed)
    ks = jax.random.split(key, 20)
    f32 = jnp.float32
    L = DEPTH

    def nrm(k, shape, fan_in):
        return jax.random.normal(k, shape, f32) * fan_in ** -0.5

    def gain(k, shape):
        return 1.0 + 0.01 * jax.random.normal(k, shape, f32)

    def small(k, shape):
        return 0.01 * jax.random.normal(k, shape, f32)

    return {
        "x": jax.random.normal(ks[0], (BATCH, SEQ, D_MODEL), f32),
        "g_attn": gain(ks[1], (L, D_MODEL)),
        "w_in": nrm(ks[2], (L, D_MODEL, IN_WIDTH), D_MODEL),
        "g_q_a": gain(ks[3], (L, Q_LORA_RANK)),
        "w_q_b": nrm(ks[4], (L, Q_LORA_RANK, MLA_HEADS * (QK_NOPE_DIM + QK_ROPE_DIM)), Q_LORA_RANK),
        "g_kv_a": gain(ks[5], (L, KV_LORA_RANK)),
        "w_kv_b": nrm(ks[6], (L, KV_LORA_RANK, MLA_HEADS * (QK_NOPE_DIM + V_HEAD_DIM)), KV_LORA_RANK),
        "b_forget": jax.random.uniform(ks[7], (L, FOX_HEADS), f32, 1.0, 4.0),
        "g_mla_out": gain(ks[8], (L, MLA_WIDTH)),
        "g_fox_out": gain(ks[9], (L, FOX_WIDTH)),
        "w_o": nrm(ks[10], (L, MIX_WIDTH, D_MODEL), MIX_WIDTH),
        "g_ffn": gain(ks[11], (L, D_MODEL)),
        "w_router": nrm(ks[12], (L, D_MODEL, N_EXPERTS), D_MODEL),
        "b_router": small(ks[13], (L, N_EXPERTS)),
        "w_gate_up": nrm(ks[14], (L, N_EXPERTS, D_MODEL, 2 * D_EXPERT), D_MODEL),
        "b_gate_up": small(ks[15], (L, N_EXPERTS, 2 * D_EXPERT)),
        "w_down": nrm(ks[16], (L, N_EXPERTS, D_EXPERT, D_MODEL), D_EXPERT),
        "b_down": small(ks[17], (L, N_EXPERTS, D_MODEL)),
        "g_final": gain(ks[18], (D_MODEL,)),
    }


def reference(x, g_attn, w_in, g_q_a, w_q_b, g_kv_a, w_kv_b, b_forget, g_mla_out, g_fox_out,
              w_o, g_ffn, w_router, b_router, w_gate_up, b_gate_up, w_down, b_down, g_final):
    pos = jnp.arange(x.shape[1], dtype=jnp.int32)
    h = x
    for l in range(DEPTH):
        h = h + hybrid_mixer(h, pos, g_attn[l], w_in[l], g_q_a[l], w_q_b[l], g_kv_a[l], w_kv_b[l],
                             b_forget[l], g_mla_out[l], g_fox_out[l], w_o[l])
        h = h + moe_ffn(h, g_ffn[l], w_router[l], b_router[l], w_gate_up[l], b_gate_up[l],
                        w_down[l], b_down[l])
    return rms_norm(h, g_final)
```

```cpp
#include <hip/hip_runtime.h>
#include <cstdio>
#include <cstdint>

#ifndef MK_ONE_LAUNCH
#define MK_ONE_LAUNCH 1
#endif
#ifndef MK_PH_END
#define MK_PH_END 10
#endif

#define LAS __attribute__((address_space(3)))
#define GAS __attribute__((address_space(1)))
typedef unsigned short bf16_t;
typedef short bf16x8 __attribute__((ext_vector_type(8)));
typedef short s16x4 __attribute__((ext_vector_type(4)));
typedef float f32x2 __attribute__((ext_vector_type(2)));
typedef float f32x4 __attribute__((ext_vector_type(4)));
typedef float f32x16 __attribute__((ext_vector_type(16)));
typedef unsigned u32x2 __attribute__((ext_vector_type(2)));
typedef unsigned u32x4 __attribute__((ext_vector_type(4)));
typedef int i32x2 __attribute__((ext_vector_type(2)));

constexpr int NB = 4, SEQ = 8192, T = NB * SEQ, DM = 2048;
constexpr int NIN = 4168;
constexpr int PW = 4096;
constexpr int NE = 32, TOPK = 4;
constexpr int QW = 1536, KVW = 2048;
constexpr float EPS = 1e-5f;
constexpr int LIST_CAP = T;
constexpr int MAX_RT = 544;

constexpr size_t MiB = 1u << 20;
constexpr size_t WS_CTL = 0, CTL_ZERO_BYTES = 2 * MiB;
constexpr size_t WS_SSQ = 1 * MiB;
constexpr size_t WS_ROPE = 2 * MiB;
constexpr size_t WS_WR = 4 * MiB;
constexpr size_t WS_FL = 5 * MiB;
constexpr size_t WS_CUM = 6 * MiB;
constexpr size_t WS_KR = 7 * MiB;
constexpr size_t WS_RE = 11 * MiB, WS_RP = WS_RE + 512 * 1024, WS_RG = WS_RP + 512 * 1024;
constexpr size_t WS_LIST = 13 * MiB;
constexpr size_t WS_LISTR = 17 * MiB;
constexpr size_t WS_WIN = 22 * MiB;
constexpr size_t WS_WQB = 39 * MiB;
constexpr size_t WS_WKVB = 41 * MiB;
constexpr size_t WS_WO = 43 * MiB;
constexpr size_t WS_WGU = 52 * MiB;
constexpr size_t WS_WDN = 564 * MiB;
constexpr size_t WS_HN = 820 * MiB;
constexpr size_t WS_PROJ = 948 * MiB;
constexpr size_t WS_QB = 1204 * MiB;
constexpr size_t WS_KV = 1300 * MiB;
constexpr size_t WS_O = 1428 * MiB;
constexpr size_t WS_XB = 1556 * MiB;
constexpr size_t WS_H = 1684 * MiB;
constexpr size_t WS_YK = 2228 * MiB;
constexpr size_t WS_END = 2772 * MiB;
constexpr int CW_TMO = 0, CW_CODE = 1;
constexpr int CW_BAR = 4096;
constexpr int CW_CNT = 16384;

constexpr int RING_BYTES = 143360;
constexpr int LDSCTL_OFF = RING_BYTES, MISC_OFF = LDSCTL_OFF + 320;
constexpr int TAB_OFF = LDSCTL_OFF + 1024;
constexpr int LDS_BYTES = 147456;
constexpr int NWAVES = 8;

#define RLX_AGENT __ATOMIC_RELAXED, __HIP_MEMORY_SCOPE_AGENT
#define LDS_WAIT() asm volatile("s_waitcnt lgkmcnt(0)" ::: "memory")
#define VM_WAIT() asm volatile("s_waitcnt vmcnt(0)" ::: "memory")
typedef GAS unsigned gu32;

__device__ __forceinline__ unsigned f2bf(float f) { unsigned u = __builtin_bit_cast(unsigned, f); return (u + 0x7fffu + ((u >> 16) & 1u)) >> 16; }
__device__ __forceinline__ unsigned pk2(float lo, float hi) { return f2bf(lo) | (f2bf(hi) << 16); }
__device__ __forceinline__ unsigned cvt_pk_bf16(float lo, float hi) { unsigned r; asm volatile("v_cvt_pk_bf16_f32 %0, %1, %2" : "=v"(r) : "v"(lo), "v"(hi)); return r; }
__device__ __forceinline__ float bf_lo(unsigned w) { return __builtin_bit_cast(float, w << 16); }
__device__ __forceinline__ float bf_hi(unsigned w) { return __builtin_bit_cast(float, w & 0xffff0000u); }
__device__ __forceinline__ float wave_sum(float v) {
#pragma unroll
    for (int o = 1; o < 64; o <<= 1) v += __shfl_xor(v, o);
    return v;
}

#define XB_TMO      128
#define XB_XCNT(j)  (256  + 64 * (j))
#define XB_XSUB(j)  (1280 + 64 * (j))
#define XB_XGEN(j)  (2304 + 64 * (j))
#define XB_TOP      3328
#define XB_TOPGEN   3392
#define XCD_BAR_WORDS 3456
#define XB_SPIN_CAP (1u << 18)

__device__ __forceinline__ unsigned xb_ld(unsigned* p)              { return __hip_atomic_load(p, __ATOMIC_RELAXED, __HIP_MEMORY_SCOPE_AGENT); }
__device__ __forceinline__ unsigned xb_add(unsigned* p, unsigned v) { return __hip_atomic_fetch_add(p, v, __ATOMIC_RELAXED, __HIP_MEMORY_SCOPE_AGENT); }
__device__ __forceinline__ unsigned xb_xcc_id() { return (unsigned)__builtin_amdgcn_s_getreg((3 << 11) | 20) & 0xFu; }
#define XB_SPIN(cond, bar) do { unsigned _sp = 0; while (cond) { __builtin_amdgcn_s_sleep(1); \
    if ((++_sp & 255u) == 0u) { if (xb_ld(&(bar)[XB_TMO])) break; if (_sp > XB_SPIN_CAP) { atomicAdd(&(bar)[XB_TMO], 1u); break; } } } } while (0)

struct XcdBarrier { unsigned* bar; unsigned x; volatile LAS unsigned* st; };

__device__ __forceinline__ XcdBarrier xcd_barrier_post(unsigned* bar, volatile LAS unsigned* st) {
    XcdBarrier b; b.bar = bar; b.x = xb_xcc_id(); b.st = st;
    if (threadIdx.x == 0) (void)xb_add(&bar[XB_XCNT(b.x)], 1u);
    return b;
}
__device__ __forceinline__ void xcd_barrier_complete(unsigned* bar, unsigned x, unsigned& nloc, unsigned& nx) {
    const unsigned G = gridDim.x * gridDim.y * gridDim.z;
    unsigned sum, cnt, mine, sp = 0u;
    for (;;) {
        sum = 0u; cnt = 0u; mine = 0u;
#pragma unroll
        for (unsigned j = 0; j < 16; ++j) { const unsigned c = xb_ld(&bar[XB_XCNT(j)]); sum += c; cnt += (c > 0u) ? 1u : 0u; mine = (j == x) ? c : mine; }
        if (sum == G) break;
        __builtin_amdgcn_s_sleep(1);
        if ((++sp & 255u) == 0u) { if (xb_ld(&bar[XB_TMO])) break; if (sp > XB_SPIN_CAP) { atomicAdd(&bar[XB_TMO], 1u); break; } }
    }
    nloc = mine > 0u ? mine : 1u; nx = cnt > 0u ? cnt : 1u;
}
__device__ __forceinline__ void xcd_barrier(const XcdBarrier& b) {
    asm volatile("s_waitcnt vmcnt(0)" ::: "memory");
    __syncthreads();
    if (threadIdx.x == 0) {
        unsigned* bar = b.bar;
        __builtin_amdgcn_s_waitcnt(0);
        unsigned nloc = b.st[0], nx = b.st[1];
        if (nloc == 0u) { xcd_barrier_complete(bar, b.x, nloc, nx); b.st[0] = nloc; b.st[1] = nx; }
        const unsigned old = xb_add(&bar[XB_XSUB(b.x)], 1u);
        const unsigned gen = old / nloc;
        if (old + 1u == (gen + 1u) * nloc) {
            __builtin_amdgcn_fence(__ATOMIC_RELEASE, "agent");
            asm volatile("s_waitcnt vmcnt(0)" ::: "memory");
            const unsigned og = xb_add(&bar[XB_TOP], 1u);
            const unsigned tg = og / nx;
            if (og + 1u == (tg + 1u) * nx) xb_add(&bar[XB_TOPGEN], 1u);
            else XB_SPIN(xb_ld(&bar[XB_TOPGEN]) == tg, bar);
            __builtin_amdgcn_fence(__ATOMIC_ACQUIRE, "agent");
            xb_add(&bar[XB_XGEN(b.x)], 1u);
            asm volatile("s_waitcnt vmcnt(0)" ::: "memory");
        } else {
            XB_SPIN(xb_ld(&bar[XB_XGEN(b.x)]) == gen, bar);
            __builtin_amdgcn_fence(__ATOMIC_ACQUIRE, "agent");
            asm volatile("s_waitcnt vmcnt(0)" ::: "memory");
        }
    }
    __syncthreads();
}

namespace pg8 {
constexpr int BM = 256, BK = 64, HALF = 128, HTB = HALF * BK * 2, STAGE_BYTES = 8 * HTB, NXCD = 8, WGM = 8;
__host__ __device__ __forceinline__ int lds_byte(int r, int c) { const int st = (r >> 4) * 2 + (c >> 5), rr = r & 15, cc = c & 31, ob = rr * 64 + cc * 2; return st * 1024 + (ob ^ (((ob >> 9) & 1) << 5)); }
__host__ __device__ __forceinline__ void stage_rc(int b, int& R, int& C) { const int st = b / 1024, sb = b % 1024, swz = sb ^ (((sb >> 9) & 1) << 5); R = (st >> 1) * 16 + swz / 64; C = (st & 1) * 32 + (swz % 64) / 2; }
__host__ __device__ __forceinline__ int perm32(int rho) { const int n = rho >> 4, i = rho & 15; return 8 * (i >> 2) + 4 * n + (i & 3); }

struct Unit { int pm, pn, e; };

struct GridOrder {
    int nM, nN, nwg, G, c;
    __device__ __forceinline__ void init(int nM_, int nN_, int G_, int c_) { nM = nM_; nN = nN_; nwg = nM * nN; G = G_; c = c_; }
    __device__ __forceinline__ bool tile(int i, int& pm, int& pn) const {
        const long L = (long)i * G + c; if (L >= nwg) return false;
        int wgid = (int)L; { const int q = nwg / NXCD, r = nwg % NXCD, xcd = wgid % NXCD, off = wgid / NXCD; wgid = (xcd < r ? xcd * (q + 1) : r * (q + 1) + (xcd - r) * q) + off; }
        const int nig = WGM * nN, gid = wgid / nig, fm = gid * WGM, gsz = (nM - fm) < WGM ? (nM - fm) : WGM;
        pm = fm + ((wgid % nig) % gsz); pn = (wgid % nig) / gsz; return true;
    }
};
struct DenseSched {
    GridOrder o; const bf16_t* A; const bf16_t* Bt; int lda, ldb;
    __device__ __forceinline__ bool next(int i, Unit& u) const { u.e = 0; return o.tile(i, u.pm, u.pn); }
    __device__ __forceinline__ const char* a_ptr(const Unit& u) const { return (const char*)(A + (size_t)u.pm * BM * lda); }
    __device__ __forceinline__ const char* b_ptr(const Unit& u) const { return (const char*)(Bt + (size_t)u.pn * BM * ldb); }
    __device__ __forceinline__ unsigned a_off(const Unit&, int) const { return 0u; }
};
struct MoeSched {
    GridOrder o; const bf16_t* A; const bf16_t* Bt; int lda, ldb, nBrows; const LAS int* tstart;
    const int* list; const gu32* cnt; bool gather;
    __device__ __forceinline__ bool next(int i, Unit& u) const {
        if (!o.tile(i, u.pm, u.pn)) return false;
        int lo = 0;
#pragma unroll
        for (int s = 16; s >= 1; s >>= 1) { if (tstart[lo + s] <= u.pm) lo += s; }
        u.e = lo; return true;
    }
    __device__ __forceinline__ const char* a_ptr(const Unit& u) const { return gather ? (const char*)A : (const char*)(A + (size_t)u.pm * BM * lda); }
    __device__ __forceinline__ const char* b_ptr(const Unit& u) const { return (const char*)(Bt + ((size_t)u.e * nBrows + (size_t)u.pn * BM) * ldb); }
    __device__ __forceinline__ unsigned a_off(const Unit& u, int r) const {
        const int rr = (u.pm - tstart[u.e]) * BM + r; const int n = (int)__hip_atomic_load(cnt + 64 * u.e, RLX_AGENT);
        int tok = list[(size_t)u.e * LIST_CAP + rr]; tok = rr < n ? tok : 0;
        return (unsigned)tok * (unsigned)(lda * 2);
    }
};

template <class Epi, class Sched, bool GATHER>
__device__ __forceinline__ void gemm_phase(LAS unsigned char* lds, const int K, const Sched& S, const Epi& E) {
    const int tid = threadIdx.x, wid = __builtin_amdgcn_readfirstlane(tid >> 6), lane = tid & 63, wr = wid >> 2, wc = wid & 3, fr = lane & 15, fq = lane >> 4;
    const int nt = K / BK;
    const int lda = S.lda, ldb = S.ldb;
    unsigned voffA[2], voffB[2]; int rowA[2];
#pragma unroll
    for (int i = 0; i < 2; ++i) { int R, C; stage_rc(tid * 16 + i * 8192, R, C); const int Rb = Epi::PERM ? ((R & ~31) + perm32(R & 31)) : R;
        rowA[i] = R; voffA[i] = GATHER ? (unsigned)(C * 2) : (unsigned)(R * lda + C) * 2u; voffB[i] = (unsigned)(Rb * ldb + C) * 2u; }
    const size_t kstep = (size_t)(BK * 2);
    const size_t hstepA = GATHER ? 0 : (size_t)HALF * lda * 2, hstepB = (size_t)HALF * ldb * 2;
    const unsigned ldsw = (unsigned)wid * 1024u;
    const int aoff = lds_byte(wr * 64 + fr, fq * 8), boff = lds_byte(wc * 32 + fr, fq * 8);
#define PG8_SA(b, h) (((b) * 2 + (h)) * HTB)
#define PG8_SB(b, h) ((4 + (b) * 2 + (h)) * HTB)
#define PG8_STAGE(bufoff, gbase, voff) do { _Pragma("unroll") for (int _i = 0; _i < 2; ++_i) \
        __builtin_amdgcn_global_load_lds((const unsigned*)((const char*)(gbase) + (voff)[_i]), (LAS unsigned*)(lds + (bufoff) + ldsw + _i * 8192), 16, 0, 0); } while (0)
#define PG8_LDA(dst, b, h) do { _Pragma("unroll") for (int m = 0; m < 4; ++m) _Pragma("unroll") for (int k = 0; k < 2; ++k) dst[m][k] = *(const LAS bf16x8*)(lds + PG8_SA(b, h) + aoff + m * 2048 + k * 1024); } while (0)
#define PG8_LDB(dst, b, h) do { _Pragma("unroll") for (int n = 0; n < 2; ++n) _Pragma("unroll") for (int k = 0; k < 2; ++k) dst[n][k] = *(const LAS bf16x8*)(lds + PG8_SB(b, h) + boff + n * 2048 + k * 1024); } while (0)
#define PG8_MMA(ai, bj, At, Bt) do { __builtin_amdgcn_s_setprio(1); _Pragma("unroll") for (int m = 0; m < 4; ++m) _Pragma("unroll") for (int n = 0; n < 2; ++n) _Pragma("unroll") for (int k = 0; k < 2; ++k) \
        acc[ai][bj][m][n] = __builtin_amdgcn_mfma_f32_16x16x32_bf16(Bt[n][k], At[m][k], acc[ai][bj][m][n], 0, 0, 0); __builtin_amdgcn_s_setprio(0); } while (0)
#define PG8_WAIT_V(n) asm volatile("s_waitcnt vmcnt(" #n ")" ::: "memory")
#define PG8_WAIT_L(n) asm volatile("s_waitcnt lgkmcnt(" #n ")" ::: "memory")
#define PG8_BAR __builtin_amdgcn_s_barrier()
#define PG8_SCHED __builtin_amdgcn_sched_barrier(0)
    Unit cur, nxt; int ui = 0;
    if (!S.next(0, cur)) return;
    f32x4 acc[2][2][4][2];
#pragma unroll
    for (int a = 0; a < 2; ++a)
#pragma unroll
        for (int b = 0; b < 2; ++b)
#pragma unroll
            for (int m = 0; m < 4; ++m)
#pragma unroll
                for (int n = 0; n < 2; ++n) acc[a][b][m][n] = (f32x4){0.f, 0.f, 0.f, 0.f};
    bf16x8 At[4][2], B0[2][2], B1[2][2];
    const char* cA = S.a_ptr(cur); const char* cB = S.b_ptr(cur);
    unsigned c0[2] = {voffA[0], voffA[1]}, c1[2] = {voffA[0], voffA[1]}, n0[2] = {voffA[0], voffA[1]}, n1[2] = {voffA[0], voffA[1]};
    if constexpr (GATHER) {
#pragma unroll
        for (int i = 0; i < 2; ++i) { c0[i] = voffA[i] + S.a_off(cur, rowA[i]); c1[i] = voffA[i] + S.a_off(cur, HALF + rowA[i]); }
    }
#define PG8_STAGE_A(bufoff, kptr, h, o0, o1) do { if constexpr (GATHER) { if ((h) == 0) PG8_STAGE(bufoff, kptr, o0); else PG8_STAGE(bufoff, kptr, o1); } \
        else { PG8_STAGE(bufoff, (kptr) + (h) * hstepA, voffA); } } while (0)
    PG8_STAGE(PG8_SB(0, 0), cB, voffB); PG8_STAGE(PG8_SB(0, 1), cB + hstepB, voffB); PG8_STAGE_A(PG8_SA(0, 0), cA, 0, c0, c1); PG8_STAGE_A(PG8_SA(0, 1), cA, 1, c0, c1);
    if (wr == 1) PG8_BAR;
    PG8_WAIT_V(2); PG8_BAR;
    PG8_STAGE(PG8_SB(1, 0), cB + kstep, voffB); PG8_STAGE_A(PG8_SA(1, 0), cA + kstep, 0, c0, c1); PG8_STAGE(PG8_SB(1, 1), cB + hstepB + kstep, voffB);
    PG8_WAIT_V(6); PG8_BAR;
    for (;;) {
        const bool has_next = S.next(ui + 1, nxt);
        const char* nA = has_next ? S.a_ptr(nxt) : cA; const char* nB = has_next ? S.b_ptr(nxt) : cB;
        if constexpr (GATHER) {
            if (has_next) {
                int t2 = threadIdx.x; asm volatile("" : "+v"(t2));
#pragma unroll
                for (int i = 0; i < 2; ++i) { int R, C; stage_rc(t2 * 16 + i * 8192, R, C); const unsigned vo = (unsigned)(C * 2); n0[i] = vo + S.a_off(nxt, R); n1[i] = vo + S.a_off(nxt, HALF + R); }
            } else {
#pragma unroll
                for (int i = 0; i < 2; ++i) { n0[i] = c0[i]; n1[i] = c1[i]; }
            }
        }
#define PG8_KBODY(a1_, a2_, b2_, X0, X1) do { const char* a3_ = (a2_) + kstep; const char* b3_ = (b2_) + kstep; \
              \
            PG8_LDB(B0, 0, 0); PG8_LDB(B1, 0, 1); PG8_SCHED; PG8_LDA(At, 0, 0); PG8_STAGE_A(PG8_SA(1, 1), a1_, 1, c0, c1); \
            PG8_WAIT_V(8); PG8_WAIT_L(0); PG8_BAR; PG8_MMA(0, 0, At, B0); PG8_MMA(0, 1, At, B1); PG8_BAR; PG8_SCHED; \
              \
            PG8_LDA(At, 0, 1); PG8_STAGE(PG8_SB(0, 0), b2_, voffB); PG8_STAGE(PG8_SB(0, 1), (b2_) + hstepB, voffB); PG8_STAGE_A(PG8_SA(0, 0), a2_, 0, X0, X1); \
            PG8_WAIT_V(8); PG8_WAIT_L(0); PG8_BAR; PG8_MMA(1, 0, At, B0); PG8_MMA(1, 1, At, B1); PG8_BAR; PG8_SCHED; \
              \
            PG8_LDB(B0, 1, 0); PG8_LDB(B1, 1, 1); PG8_SCHED; PG8_LDA(At, 1, 0); PG8_STAGE_A(PG8_SA(0, 1), a2_, 1, X0, X1); \
            PG8_WAIT_V(8); PG8_WAIT_L(0); PG8_BAR; PG8_MMA(0, 0, At, B0); PG8_MMA(0, 1, At, B1); PG8_BAR; PG8_SCHED; \
              \
            PG8_LDA(At, 1, 1); PG8_STAGE(PG8_SB(1, 0), b3_, voffB); PG8_STAGE(PG8_SB(1, 1), b3_ + hstepB, voffB); PG8_STAGE_A(PG8_SA(1, 0), a3_, 0, X0, X1); \
            PG8_WAIT_V(8); PG8_WAIT_L(0); PG8_BAR; PG8_MMA(1, 0, At, B0); PG8_MMA(1, 1, At, B1); PG8_BAR; PG8_SCHED; } while (0)
        if constexpr (GATHER) {
            for (int t = 0; t < nt - 2; t += 2) { const char* a1 = cA + (size_t)(t + 1) * kstep; const char* a2 = cA + (size_t)(t + 2) * kstep; const char* b2 = cB + (size_t)(t + 2) * kstep; PG8_KBODY(a1, a2, b2, c0, c1); }
            { const char* a1 = cA + (size_t)(nt - 1) * kstep; PG8_KBODY(a1, nA, nB, n0, n1); }
        } else {
            for (int t = 0; t < nt; t += 2) {
                const bool last = (t == nt - 2);
                const char* a1 = cA + (size_t)(t + 1) * kstep;
                const char* a2 = last ? nA : cA + (size_t)(t + 2) * kstep; const char* b2 = last ? nB : cB + (size_t)(t + 2) * kstep;
                PG8_KBODY(a1, a2, b2, c0, c1);
            }
        }
        if (wr == 0) PG8_BAR;
        { int t2 = threadIdx.x; asm volatile("" : "+v"(t2)); const int l2 = t2 & 63, w2 = t2 >> 6;
          E(acc, cur, w2 >> 2, w2 & 3, l2 & 15, l2 >> 4); }
        if (!has_next) break;
#pragma unroll
        for (int a = 0; a < 2; ++a)
#pragma unroll
            for (int b = 0; b < 2; ++b)
#pragma unroll
                for (int m = 0; m < 4; ++m)
#pragma unroll
                    for (int n = 0; n < 2; ++n) acc[a][b][m][n] = (f32x4){0.f, 0.f, 0.f, 0.f};
        cur = nxt; cA = nA; cB = nB; ++ui;
#pragma unroll
        for (int i = 0; i < 2; ++i) { c0[i] = n0[i]; c1[i] = n1[i]; }
        if (wr == 1) PG8_BAR;
    }
    PG8_WAIT_V(0);
    PG8_BAR;
#undef PG8_SA
#undef PG8_SB
#undef PG8_STAGE
#undef PG8_STAGE_A
#undef PG8_KBODY
#undef PG8_LDA
#undef PG8_LDB
#undef PG8_MMA
#undef PG8_WAIT_V
#undef PG8_WAIT_L
#undef PG8_BAR
#undef PG8_SCHED
}
}

namespace att {
constexpr int NW = 8, QBLK = 32, KVBLK = 64, QB = NW * QBLK;
constexpr int SHM_V = KVBLK * 128 * 2, KP = 272, SHM_K = KVBLK * KP, KRP = 144, SHM_KR = KVBLK * KRP, QLP = 208, SHM_QR = QBLK * QLP;
constexpr int OFF_V = 0, OFF_K = 2 * SHM_V, OFF_KR = OFF_K + 2 * SHM_K, OFF_WS = OFF_KR + 2 * SHM_KR, OFF_NC = OFF_WS + NW * 64 * 4, OFF_QR = OFF_NC + 2 * 256, LDS_BYTES = OFF_QR + NW * SHM_QR;
constexpr int LDO = 2048;
#define KSWZ(row, colB) ((row) * KP + (colB))
#define KRSWZ(row, colB) ((row) * KRP + (colB))
#define SBAR() __builtin_amdgcn_sched_barrier(0)
__device__ __forceinline__ int v_st(int k, int c) { const int kk = (k & ~0xC) | ((k & 4) << 1) | ((k & 8) >> 1); return ((kk >> 3) * 4 + (c >> 5)) * 512 + ((kk & 7) * 32 + (c & 31)) * 2; }
__device__ __forceinline__ int v_rd_base(int lane) { return ((lane & 3) << 3) | (((lane >> 2) & 3) << 6) | (((lane >> 4) & 1) << 5) | (((lane >> 5) & 1) << 8); }
constexpr int v_rd_off(int d0, int ks, int half) { return d0 * 512 + ks * 4096 + half * 2048; }
__device__ __forceinline__ int crow(int r, int hi) { return (r & 3) + 8 * (r >> 2) + 4 * hi; }
__device__ __forceinline__ bf16x8 load8(const bf16_t* p) { return *reinterpret_cast<const bf16x8*>(p); }
__device__ __forceinline__ void mask_tile(f32x16& p0, f32x16& p1, int dq) {
    const float NEG = -__builtin_inff();
#pragma unroll
    for (int r = 0; r < 16; ++r) {
        const int c = (r & 3) + 8 * (r >> 2);
        if (dq - c < 0) p0[r] = NEG;
        if (dq - c - 32 < 0) p1[r] = NEG;
    }
}
template <int DK>
__device__ __forceinline__ void partialSM(f32x16& p0, f32x16& p1, float& m_reg, float& mn, float& alpha) {
    constexpr float SCALE = DK == 128 ? 0.08838834764831845f : 0.07216878364870323f, THR = 8.f;
    float pmax = p0[0];
#pragma unroll
    for (int r = 1; r < 16; ++r) pmax = fmaxf(pmax, p0[r]);
#pragma unroll
    for (int r = 0; r < 16; ++r) pmax = fmaxf(pmax, p1[r]);
    { auto rr = __builtin_amdgcn_permlane32_swap(__float_as_uint(pmax), __float_as_uint(pmax), false, false);
      pmax = fmaxf(__uint_as_float(rr[0]), __uint_as_float(rr[1])); }
    constexpr float C2 = 1.4426950408889634f * SCALE;
    if (__builtin_expect(__all((pmax - m_reg) * SCALE <= THR), 1)) { mn = m_reg; alpha = 1.f; }
    else { mn = fmaxf(m_reg, pmax); alpha = __builtin_amdgcn_exp2f((m_reg - mn) * C2); m_reg = mn; }
    const float mnL = -mn * C2;
#pragma unroll
    for (int r = 0; r < 16; ++r) p0[r] = fmaf(p0[r], C2, mnL);
#pragma unroll
    for (int r = 0; r < 16; ++r) p1[r] = fmaf(p1[r], C2, mnL);
#pragma unroll
    for (int r = 0; r < 16; ++r) p0[r] = __builtin_amdgcn_exp2f(p0[r]);
}
__device__ __forceinline__ void finishSM(f32x16& p0, f32x16& p1, float alpha, float& l_reg, bf16x8& pa0, bf16x8& pa1, bf16x8& pa2, bf16x8& pa3) {
#pragma unroll
    for (int r = 0; r < 16; ++r) p1[r] = __builtin_amdgcn_exp2f(p1[r]);
    float ps = 0;
#pragma unroll
    for (int r = 0; r < 16; ++r) ps += p0[r];
#pragma unroll
    for (int r = 0; r < 16; ++r) ps += p1[r];
    { auto rr = __builtin_amdgcn_permlane32_swap(__float_as_uint(ps), __float_as_uint(ps), false, false);
      ps = __uint_as_float(rr[0]) + __uint_as_float(rr[1]); }
    l_reg = l_reg * alpha + ps;
#define PK4(P, B_, OUT) do { unsigned a0 = cvt_pk_bf16(P[B_+0], P[B_+1]), a1 = cvt_pk_bf16(P[B_+2], P[B_+3]);                  \
        unsigned b0 = cvt_pk_bf16(P[B_+4], P[B_+5]), b1 = cvt_pk_bf16(P[B_+6], P[B_+7]);                                       \
        auto r0 = __builtin_amdgcn_permlane32_swap(a0, b0, false, false); auto r1 = __builtin_amdgcn_permlane32_swap(a1, b1, false, false); \
        u32x4 w = {r0[0], r1[0], r0[1], r1[1]}; OUT = *reinterpret_cast<bf16x8*>(&w); } while (0)
    PK4(p0, 0, pa0); PK4(p0, 8, pa1); PK4(p1, 0, pa2); PK4(p1, 8, pa3);
#undef PK4
}
template <int KB, int DK, bool BIAS>
__device__ __forceinline__ void qkt(f32x16& p0, f32x16& p1, const char* lds, int r32, int hi, const bf16x8* qr, const char* qrl) {
    if constexpr (BIAS) {
        const float* nc = (const float*)(lds + OFF_NC + KB * 256);
#pragma unroll
        for (int g = 0; g < 4; ++g) { const f32x4 a = *(const f32x4*)(nc + 8 * g + 4 * hi), b = *(const f32x4*)(nc + 32 + 8 * g + 4 * hi);
            p0[4 * g] = a[0]; p0[4 * g + 1] = a[1]; p0[4 * g + 2] = a[2]; p0[4 * g + 3] = a[3];
            p1[4 * g] = b[0]; p1[4 * g + 1] = b[1]; p1[4 * g + 2] = b[2]; p1[4 * g + 3] = b[3]; }
    } else { p0 = f32x16{}; p1 = f32x16{}; }
    constexpr int NQREG = DK == 192 ? 6 : 8;
    const char* kb = lds + OFF_K + KB * SHM_K + r32 * KP + hi * 16;
#pragma unroll
    for (int d0 = 0; d0 < 8; ++d0) {
        bf16x8 b0 = *reinterpret_cast<const bf16x8*>(kb + d0 * 32);
        bf16x8 b1 = *reinterpret_cast<const bf16x8*>(kb + d0 * 32 + 32 * KP);
        bf16x8 q; if (d0 < NQREG) q = qr[d0]; else q = *reinterpret_cast<const bf16x8*>(qrl + (d0 - NQREG) * 32);
        p0 = __builtin_amdgcn_mfma_f32_32x32x16_bf16(b0, q, p0, 0, 0, 0);
        p1 = __builtin_amdgcn_mfma_f32_32x32x16_bf16(b1, q, p1, 0, 0, 0); }
    if constexpr (DK == 192) {
        const char* kr = lds + OFF_KR + KB * SHM_KR + r32 * KRP + hi * 16;
#pragma unroll
        for (int d0 = 0; d0 < 4; ++d0) {
            const bf16x8 b0 = *reinterpret_cast<const bf16x8*>(kr + d0 * 32);
            const bf16x8 b1 = *reinterpret_cast<const bf16x8*>(kr + d0 * 32 + 32 * KRP);
            const bf16x8 q = *reinterpret_cast<const bf16x8*>(qrl + (8 - NQREG + d0) * 32);
            p0 = __builtin_amdgcn_mfma_f32_32x32x16_bf16(b0, q, p0, 0, 0, 0);
            p1 = __builtin_amdgcn_mfma_f32_32x32x16_bf16(b1, q, p1, 0, 0, 0); }
    }
}
template <int VB>
__device__ __forceinline__ void pv_tile(f32x16* o, int vb0, bf16x8 pa0, bf16x8 pa1, bf16x8 pa2, bf16x8 pa3) {
#define TRRD(dst, off) asm volatile("ds_read_b64_tr_b16 %0, %1 offset:%2" : "=&v"(dst) : "v"(vb0), "i"(off) : "memory")
#define PV_D0(d0) do { s16x4 l0, l1, l2, l3, h0, h1, h2, h3; constexpr int b_ = VB * SHM_V + v_rd_off(d0, 0, 0); \
        TRRD(l0, b_); TRRD(h0, b_ + 2048); TRRD(l1, b_ + 4096); TRRD(h1, b_ + 6144); TRRD(l2, b_ + 8192); TRRD(h2, b_ + 10240); TRRD(l3, b_ + 12288); TRRD(h3, b_ + 14336); \
        asm volatile("s_waitcnt lgkmcnt(0)" ::: "memory"); SBAR(); \
        o[d0] = __builtin_amdgcn_mfma_f32_32x32x16_bf16(pa0, (bf16x8){l0[0], l0[1], l0[2], l0[3], h0[0], h0[1], h0[2], h0[3]}, o[d0], 0, 0, 0);   \
        o[d0] = __builtin_amdgcn_mfma_f32_32x32x16_bf16(pa1, (bf16x8){l1[0], l1[1], l1[2], l1[3], h1[0], h1[1], h1[2], h1[3]}, o[d0], 0, 0, 0);   \
        o[d0] = __builtin_amdgcn_mfma_f32_32x32x16_bf16(pa2, (bf16x8){l2[0], l2[1], l2[2], l2[3], h2[0], h2[1], h2[2], h2[3]}, o[d0], 0, 0, 0);   \
        o[d0] = __builtin_amdgcn_mfma_f32_32x32x16_bf16(pa3, (bf16x8){l3[0], l3[1], l3[2], l3[3], h3[0], h3[1], h3[2], h3[3]}, o[d0], 0, 0, 0); } while (0)
    PV_D0(0); PV_D0(1); PV_D0(2); PV_D0(3);
#undef PV_D0
#undef TRRD
}

struct BlockRef { const bf16_t* Q; const bf16_t* K; const bf16_t* V; const bf16_t* KR; const float* NC; bf16_t* O; int P0; };
template <int DK> struct Seam { bf16x8 qr[8]; bf16x8 st_v0, st_v1, st_k0, st_k1, st_kr; float st_c; };

#define VMW() asm volatile("s_waitcnt vmcnt(0)" ::: "memory")
#define VMWN(n) asm volatile("s_waitcnt vmcnt(%0)" :: "i"(n) : "memory")
#define AT_SLOAD(R, k0) do { S.st_v0 = load8((R).V + (size_t)((k0) + sr) * LDV + sc); S.st_v1 = load8((R).V + (size_t)((k0) + 32 + sr) * LDV + sc);              \
                             S.st_k0 = load8((R).K + (size_t)((k0) + sr) * LDK + sc); S.st_k1 = load8((R).K + (size_t)((k0) + 32 + sr) * LDK + sc);              \
                             if constexpr (DK == 192) S.st_kr = load8((R).KR + (size_t)((k0) + (tid >> 3)) * 64 + (tid & 7) * 8);                              \
                             if constexpr (BIAS) { if (tid < 64) S.st_c = (R).NC[(k0) + tid]; } } while (0)
#define AT_SWRITE_K(bf) do { *(bf16x8*)(K_lds + (bf) * SHM_K + kws) = S.st_k0; *(bf16x8*)(K_lds + (bf) * SHM_K + kws + 32 * KP) = S.st_k1;                      \
                             if constexpr (DK == 192) *(bf16x8*)(lds + OFF_KR + (bf) * SHM_KR + krws) = S.st_kr;                                                \
                             if constexpr (BIAS) { if (tid < 64) ((float*)(lds + OFF_NC + (bf) * 256))[tid] = S.st_c; } } while (0)
#define AT_SWRITE_V(bf) do { *(bf16x8*)(V_lds + (bf) * SHM_V + vst0) = S.st_v0; *(bf16x8*)(V_lds + (bf) * SHM_V + vst1) = S.st_v1; } while (0)

template <int DK, bool BIAS, int LDQ, int LDK, int LDV>
__device__ __forceinline__ void prime(const BlockRef& cur, char* lds, Seam<DK>& S) {
    const int tid = threadIdx.x, wid = __builtin_amdgcn_readfirstlane(tid >> 6), lane = tid & 63, r32 = lane & 31, hi = lane >> 5;
    const int sr = tid >> 4, sc = (tid & 15) * 8, kws = KSWZ(sr, sc * 2), krws = KRSWZ(tid >> 3, (tid & 7) * 16); char* K_lds = lds + OFF_K;
    constexpr int NQREG = DK == 192 ? 6 : 8;
#pragma unroll
    for (int d0 = 0; d0 < NQREG; ++d0) S.qr[d0] = load8(cur.Q + (size_t)(wid * QBLK + r32) * LDQ + d0 * 16 + hi * 8);
    if constexpr (DK == 192) { char* qrl = lds + OFF_QR + wid * SHM_QR + r32 * QLP + hi * 16;
#pragma unroll
        for (int d0 = NQREG; d0 < 12; ++d0) *(bf16x8*)(qrl + (d0 - NQREG) * 32) = load8(cur.Q + (size_t)(wid * QBLK + r32) * LDQ + d0 * 16 + hi * 8); }
    AT_SLOAD(cur, 0); VMW(); AT_SWRITE_K(0);
    __syncthreads();
}
template <int DK, bool BIAS, int LDQ, int LDK, int LDV>
__device__ __forceinline__ void block(const BlockRef& cur, const BlockRef& nxt, char* lds, Seam<DK>& S) {
    const int tid = threadIdx.x, wid = __builtin_amdgcn_readfirstlane(tid >> 6), lane = tid & 63, r32 = lane & 31, hi = lane >> 5;
    const int NT = (cur.P0 + QB) / KVBLK;
    const int qlo = cur.P0 + wid * QBLK, qm = qlo + r32 - 4 * hi;
    char* V_lds = lds + OFF_V; char* K_lds = lds + OFF_K;
    float* ws = (float*)(lds + OFF_WS) + wid * 64; float* li_l = ws, * al_l = ws + 32;
    float m_reg = -1e30f, l_reg = 0; f32x16 o[4] = {};
    const int sr = tid >> 4, sc = (tid & 15) * 8, vst0 = v_st(sr, sc), vst1 = v_st(32 + sr, sc), kws = KSWZ(sr, sc * 2), krws = KRSWZ(tid >> 3, (tid & 7) * 16);
    const int vb0 = (int)(uintptr_t)V_lds + v_rd_base(lane);
    char* qrl = lds + OFF_QR + wid * SHM_QR + r32 * QLP + hi * 16;
    constexpr int NQREG = DK == 192 ? 6 : 8;
#define RESC(a) do { if (__any((a) < 1.f)) { if (hi == 0) al_l[r32] = (a); asm volatile("s_waitcnt lgkmcnt(0)" ::: "memory");              \
                     for (int d_ = 0; d_ < 4; ++d_) for (int r = 0; r < 16; ++r) o[d_][r] *= al_l[crow(r, hi)]; } } while (0)
#define KBASE(t) ((t) * KVBLK)
#define MASKT(P0_, P1_, t) do { const int kb_ = KBASE(t); if (kb_ + KVBLK - 1 > qlo) mask_tile(P0_, P1_, qm - kb_); } while (0)
    constexpr int NQL = NQREG;
#define SEAM_K0() do { VMWN(NQL); AT_SWRITE_K(0); SBAR(); } while (0)
    f32x16 pA0, pA1, pB0, pB1; float mnA, mnB, alA, alB; bf16x8 pa0, pa1, pa2, pa3;
    AT_SWRITE_V(0); SBAR();
    if (NT > 1) AT_SLOAD(cur, KBASE(1));
    SBAR(); qkt<0, DK, BIAS>(pA0, pA1, lds, r32, hi, S.qr, qrl);
    MASKT(pA0, pA1, 0); partialSM<DK>(pA0, pA1, m_reg, mnA, alA);
    if (NT > 1) { VMW(); AT_SWRITE_V(1); AT_SWRITE_K(1); }
    __syncthreads();
#define HALF_STEP(PX0, PX1, mnX, alX, PY0, PY1, alY, t, KB, VB, SB) do {                                                      \
        SBAR(); qkt<KB, DK, BIAS>(PX0, PX1, lds, r32, hi, S.qr, qrl);                                                              \
        finishSM(PY0, PY1, alY, l_reg, pa0, pa1, pa2, pa3); SBAR();                                                           \
        if ((t) + 1 < NT) { AT_SLOAD(cur, KBASE((t) + 1)); SBAR(); }                                                          \
        pv_tile<VB>(o, vb0, pa0, pa1, pa2, pa3); MASKT(PX0, PX1, (t)); partialSM<DK>(PX0, PX1, m_reg, mnX, alX);               \
        __syncthreads();                                                                                                      \
        if ((t) + 1 < NT) { VMW(); AT_SWRITE_V(SB); AT_SWRITE_K(SB); }                                                        \
        RESC(alX); __syncthreads(); } while (0)
    for (int t = 1; t + 1 < NT; t += 2) {
        HALF_STEP(pB0, pB1, mnB, alB, pA0, pA1, alA, t, 1, 0, 0);
        HALF_STEP(pA0, pA1, mnA, alA, pB0, pB1, alB, t + 1, 0, 1, 1);
    }
    const bool even = (NT & 1) == 0;
    if (even) { SBAR(); qkt<1, DK, BIAS>(pB0, pB1, lds, r32, hi, S.qr, qrl); SBAR(); }
    AT_SLOAD(nxt, 0); SBAR();
#pragma unroll
    for (int d0 = 0; d0 < NQREG; ++d0) S.qr[d0] = load8(nxt.Q + (size_t)(wid * QBLK + r32) * LDQ + d0 * 16 + hi * 8);
    SBAR();
    finishSM(pA0, pA1, alA, l_reg, pa0, pa1, pa2, pa3); SBAR();
    pv_tile<0>(o, vb0, pa0, pa1, pa2, pa3);
    if (even) { MASKT(pB0, pB1, NT - 1); partialSM<DK>(pB0, pB1, m_reg, mnB, alB); __syncthreads(); RESC(alB);
        finishSM(pB0, pB1, alB, l_reg, pa0, pa1, pa2, pa3); SBAR(); pv_tile<1>(o, vb0, pa0, pa1, pa2, pa3); }
    SBAR(); SEAM_K0();
    if constexpr (DK == 192) {
#pragma unroll
        for (int d0 = NQREG; d0 < 12; ++d0) *(bf16x8*)(qrl + (d0 - NQREG) * 32) = load8(nxt.Q + (size_t)(wid * QBLK + r32) * LDQ + d0 * 16 + hi * 8);
        SBAR(); }
    if (hi == 0) li_l[r32] = l_reg; asm volatile("s_waitcnt lgkmcnt(0)" ::: "memory");
    float rli[16];
#pragma unroll
    for (int r = 0; r < 16; ++r) rli[r] = __builtin_amdgcn_rcpf(li_l[crow(r, hi)]);
    bf16_t* Ow = cur.O + (size_t)(wid * QBLK) * LDO;
#pragma unroll
    for (int r = 0; r < 16; ++r) { const int orow = crow(r, hi);
#pragma unroll
        for (int d0 = 0; d0 < 4; ++d0) { const float v = o[d0][r] * rli[r];
            const float vn = __shfl_xor(v, 1);
            if ((r32 & 1) == 0) *(unsigned*)(Ow + (size_t)orow * LDO + d0 * 32 + r32) = cvt_pk_bf16(v, vn); } }
    __syncthreads();
#undef RESC
#undef KBASE
#undef MASKT
#undef SEAM_K0
#undef HALF_STEP
}
#undef VMW
#undef VMWN
#undef AT_SLOAD
#undef AT_SWRITE_K
#undef AT_SWRITE_V
}

static_assert(att::LDS_BYTES <= RING_BYTES && pg8::STAGE_BYTES <= RING_BYTES && TAB_OFF + 34 * 4 <= LDS_BYTES, "LDS map");
struct Args { const float* in[19]; float* out; unsigned char* ws; int ph_lo, ph_hi; };
struct Frame {
    LAS unsigned char* lds; volatile LAS unsigned* MISC; gu32* ctl; unsigned char* ws;
    int tid, lane, wave, vcu, G;
};

template <class Map>
__device__ __forceinline__ void tr_item(const float* W, int K, int N, bf16_t* WT, const float* gain, LAS float* scr, int item, int lane, Map dmap) {
    const int nblk = (N + 31) / 32, kb = item / nblk, nb = item % nblk, k0 = 64 * kb, n0 = 32 * nb;
    const int cc = n0 + (lane & 31);
#pragma unroll 8
    for (int i = 0; i < 32; ++i) { const int kk = 2 * i + (lane >> 5); float v = 0.f; if (cc < N) { v = W[(size_t)(k0 + kk) * N + cc]; if (gain) v *= gain[k0 + kk]; } scr[kk * 33 + (lane & 31)] = v; }
    LDS_WAIT(); asm volatile("" ::: "memory");
    const int c = lane & 7;
#pragma unroll
    for (int j = 0; j < 4; ++j) { const int n = (lane >> 3) + 8 * j; const LAS float* s = scr + (8 * c) * 33 + n;
        u32x4 o; o.x = pk2(s[0 * 33], s[1 * 33]); o.y = pk2(s[2 * 33], s[3 * 33]); o.z = pk2(s[4 * 33], s[5 * 33]); o.w = pk2(s[6 * 33], s[7 * 33]);
        if (n0 + n < N) { const int d = dmap(n0 + n); if (d >= 0) *(GAS u32x4*)(WT + (size_t)d * K + k0 + 8 * c) = o; } }
    LDS_WAIT(); asm volatile("" ::: "memory");
}
struct MapId { __device__ __forceinline__ int operator()(int c) const { return c; } };
struct MapWin {
    __device__ __forceinline__ int operator()(int c) const {
        if (c < 1024) return c;
        if (c < 1088) { const int i = c - 1024; return 4096 + (i < 32 ? 2 * i : 2 * (i - 32) + 1); }
        if (c < 4160) return c - 64;
        return 4160 + (c - 4160);
    }
};
struct MapWq {
    __device__ __forceinline__ int operator()(int c) const { const int h = c / 192, j = c % 192; if (j < 128) return c; const int i = j - 128; return h * 192 + 128 + (i < 32 ? 2 * i : 2 * (i - 32) + 1); }
};
struct MapGu {
    __device__ __forceinline__ int operator()(int c) const { const int f = c & 2047; return (f >> 7) * 256 + (c >> 11) * 128 + (f & 127); }
};

__device__ __forceinline__ void p0_prologue(Frame& F, const Args& a) {
    LAS float* scr = (LAS float*)(F.lds + F.wave * 16384);
    const int gw = F.vcu * NWAVES + F.wave, NGW = F.G * NWAVES;
    const float* x = a.in[0]; const float* g_attn = a.in[1]; const float* w_in = a.in[2]; const float* g_q_a = a.in[3]; const float* w_q_b = a.in[4];
    const float* g_kv_a = a.in[5]; const float* w_kv_b = a.in[6]; const float* g_mla = a.in[8]; const float* g_fox = a.in[9]; const float* w_o = a.in[10];
    const float* g_ffn = a.in[11]; const float* w_router = a.in[12]; const float* w_gu = a.in[14]; const float* w_dn = a.in[16];
    bf16_t* WIN = (bf16_t*)(F.ws + WS_WIN); bf16_t* WQB = (bf16_t*)(F.ws + WS_WQB); bf16_t* WKVB = (bf16_t*)(F.ws + WS_WKVB); bf16_t* WO = (bf16_t*)(F.ws + WS_WO);
    bf16_t* WGU = (bf16_t*)(F.ws + WS_WGU); bf16_t* WDN = (bf16_t*)(F.ws + WS_WDN); bf16_t* HN = (bf16_t*)(F.ws + WS_HN);
    constexpr int I_GU1 = (DM / 64) * (4096 / 32), I_GU = NE * I_GU1, I_DN1 = (DM / 64) * (DM / 32), I_DN = NE * I_DN1;
    constexpr int I_IN = (DM / 64) * ((NIN + 31) / 32), I_QB = (512 / 64) * (QW / 32), I_KVB = (512 / 64) * (KVW / 32), I_O = (DM / 64) * (DM / 32);
    constexpr int NITEMS = I_GU + I_DN + I_IN + I_QB + I_KVB + I_O;
    for (int it = gw; it < NITEMS; it += NGW) {
        int r = it;
        if (r < I_GU) { const int e = r / I_GU1; tr_item(w_gu + (size_t)e * DM * 4096, DM, 4096, WGU + (size_t)e * 4096 * DM, g_ffn, scr, r % I_GU1, F.lane, MapGu()); continue; } r -= I_GU;
        if (r < I_DN) { const int e = r / I_DN1; tr_item(w_dn + (size_t)e * DM * DM, DM, DM, WDN + (size_t)e * DM * DM, nullptr, scr, r % I_DN1, F.lane, MapId()); continue; } r -= I_DN;
        if (r < I_IN) { tr_item(w_in, DM, NIN, WIN, nullptr, scr, r, F.lane, MapWin()); continue; } r -= I_IN;
        if (r < I_QB) { tr_item(w_q_b, 512, QW, WQB, g_q_a, scr, r, F.lane, MapWq()); continue; } r -= I_QB;
        if (r < I_KVB) { tr_item(w_kv_b, 512, KVW, WKVB, g_kv_a, scr, r, F.lane, MapId()); continue; } r -= I_KVB;
        { const int kb = r / (DM / 32); tr_item(w_o, DM, DM, WO, (64 * kb < 1024) ? g_mla + 0 : g_fox - 1024, scr, r, F.lane, MapId()); }
    }
    { const int gt = F.vcu * 512 + F.tid, NT_ = F.G * 512; u32x4 z = {0u, 0u, 0u, 0u};
      for (int i = gt; i < (4352 - 4168) * (DM / 8); i += NT_) *(GAS u32x4*)(WIN + (size_t)4168 * DM + (size_t)i * 8) = z; }
    { const int gt = F.vcu * 512 + F.tid, NT_ = F.G * 512; float* WR = (float*)(F.ws + WS_WR);
      for (int i = gt; i < DM * NE; i += NT_) WR[i] = w_router[i] * g_ffn[i >> 5]; }
    { const int gt = F.vcu * 512 + F.tid, NT_ = F.G * 512; f32x2* RT = (f32x2*)(F.ws + WS_ROPE);
      for (int i = gt; i < SEQ * 32; i += NT_) {
          const int pos = i >> 5, fi = i & 31;
          const float invf = (float)exp2(-(double)fi * (13.287712379549449 / 32.0));
          const float ang = (float)pos * invf;
          double rev = (double)ang * 0.15915494309189535; rev -= __builtin_floor(rev + 0.5);
          const double r = rev * 6.283185307179586, r2 = r * r;
          double sn = 1.0, cs = 1.0;
#pragma unroll
          for (int n = 13; n >= 1; --n) sn = 1.0 - sn * r2 / (double)((2 * n) * (2 * n + 1));
#pragma unroll
          for (int n = 14; n >= 1; --n) cs = 1.0 - cs * r2 / (double)((2 * n - 1) * (2 * n));
          RT[i] = (f32x2){(float)cs, (float)(sn * r)};
      } }
    for (int m = gw; m < T; m += NGW) {
        const GAS f32x4* xr = (const GAS f32x4*)(x + (size_t)m * DM) + F.lane;
        f32x4 v[8]; float s = 0.f;
#pragma unroll
        for (int j = 0; j < 8; ++j) { v[j] = xr[64 * j]; s += (v[j].x * v[j].x + v[j].y * v[j].y) + (v[j].z * v[j].z + v[j].w * v[j].w); }
        const float rstd = 1.f / sqrtf(wave_sum(s) * (1.f / DM) + EPS);
        GAS u32x2* o8 = (GAS u32x2*)(HN + (size_t)m * DM) + F.lane;
#pragma unroll
        for (int j = 0; j < 8; ++j) { const f32x4 g = *((const GAS f32x4*)g_attn + 64 * j + F.lane);
            o8[64 * j] = (u32x2){pk2(v[j].x * rstd * g.x, v[j].y * rstd * g.y), pk2(v[j].z * rstd * g.z, v[j].w * rstd * g.w)}; }
    }
}

using pg8::Unit;
typedef f32x4 Acc[2][2][4][2];
__device__ __forceinline__ u32x4 pack8v(f32x4 a, f32x4 b) { u32x4 w; w.x = cvt_pk_bf16(a[0], a[1]); w.y = cvt_pk_bf16(a[2], a[3]); w.z = cvt_pk_bf16(b[0], b[1]); w.w = cvt_pk_bf16(b[2], b[3]); return w; }
__device__ __forceinline__ f32x4 rope4(f32x4 v, f32x2 cs0, f32x2 cs1) {
    return (f32x4){v[0] * cs0.x - v[1] * cs0.y, v[1] * cs0.x + v[0] * cs0.y, v[2] * cs1.x - v[3] * cs1.y, v[3] * cs1.x + v[2] * cs1.y};
}
struct EpiP1 {
    static constexpr bool PERM = true;
    bf16_t* PROJ; bf16_t* KR; float* FL; float* ssq; const f32x2* rope;
    __device__ __forceinline__ void operator()(const Acc& acc, const Unit& u, int wr, int wc, int fr, int fq) const {
        const int row0 = u.pm * 256 + wr * 64 + fr;
        if (u.pn < 16) {
            const int col0 = u.pn * 256 + wc * 32 + 8 * fq;
#pragma unroll
            for (int ai = 0; ai < 2; ++ai)
#pragma unroll
                for (int m = 0; m < 4; ++m) { const int row = row0 + ai * 128 + m * 16; bf16_t* rowp = PROJ + (size_t)row * PW + col0; float s = 0.f;
#pragma unroll
                    for (int bj = 0; bj < 2; ++bj) { const f32x4 v0 = acc[ai][bj][m][0], v1 = acc[ai][bj][m][1];
                        s += (v0[0] * v0[0] + v0[1] * v0[1]) + (v0[2] * v0[2] + v0[3] * v0[3]) + (v1[0] * v1[0] + v1[1] * v1[1]) + (v1[2] * v1[2] + v1[3] * v1[3]);
                        *(u32x4*)(rowp + bj * 128) = pack8v(v0, v1); }
                    if (u.pn < 4) { s += __shfl_xor(s, 16); s += __shfl_xor(s, 32); if (fq == 0) atomicAdd(ssq + (size_t)(u.pn >> 1) * T + row, s); } }
        } else {
#pragma unroll
            for (int ai = 0; ai < 2; ++ai)
#pragma unroll
                for (int m = 0; m < 4; ++m) { const int row = row0 + ai * 128 + m * 16; const f32x4 v0 = acc[ai][0][m][0], v1 = acc[ai][0][m][1];
                    if (wc < 2) { const int c = wc * 32 + 8 * fq; const f32x2* rt = rope + (size_t)(row & (SEQ - 1)) * 32 + (c >> 1);
                        *(u32x4*)(KR + (size_t)row * 64 + c) = pack8v(rope4(v0, rt[0], rt[1]), rope4(v1, rt[2], rt[3])); }
                    else if (wc == 2 && fq == 0) { *(f32x4*)(FL + (size_t)row * 8) = v0; *(f32x4*)(FL + (size_t)row * 8 + 4) = v1; } }
        }
    }
};
struct EpiQ {
    static constexpr bool PERM = true;
    bf16_t* Q; const float* ssq; const f32x2* rope;
    __device__ __forceinline__ void operator()(const Acc& acc, const Unit& u, int wr, int wc, int fr, int fq) const {
        const int row0 = u.pm * 256 + wr * 64 + fr, col0 = u.pn * 256 + wc * 32 + 8 * fq;
#pragma unroll
        for (int ai = 0; ai < 2; ++ai)
#pragma unroll
            for (int m = 0; m < 4; ++m) { const int row = row0 + ai * 128 + m * 16; const float rs = 1.f / sqrtf(ssq[row] * (1.f / 512.f) + EPS);
#pragma unroll
                for (int bj = 0; bj < 2; ++bj) { const int c = col0 + bj * 128, j = c % 192; f32x4 v0 = acc[ai][bj][m][0] * rs, v1 = acc[ai][bj][m][1] * rs;
                    if (j >= 128) { const f32x2* rt = rope + (size_t)(row & (SEQ - 1)) * 32 + ((j - 128) >> 1); v0 = rope4(v0, rt[0], rt[1]); v1 = rope4(v1, rt[2], rt[3]); }
                    *(u32x4*)(Q + (size_t)row * QW + c) = pack8v(v0, v1); } }
    }
};
struct EpiKV {
    static constexpr bool PERM = true;
    bf16_t* KV; const float* ssq;
    __device__ __forceinline__ void operator()(const Acc& acc, const Unit& u, int wr, int wc, int fr, int fq) const {
        const int row0 = u.pm * 256 + wr * 64 + fr, col0 = u.pn * 256 + wc * 32 + 8 * fq;
#pragma unroll
        for (int ai = 0; ai < 2; ++ai)
#pragma unroll
            for (int m = 0; m < 4; ++m) { const int row = row0 + ai * 128 + m * 16; const float rs = 1.f / sqrtf(ssq[row] * (1.f / 512.f) + EPS);
#pragma unroll
                for (int bj = 0; bj < 2; ++bj) *(u32x4*)(KV + (size_t)row * KVW + col0 + bj * 128) = pack8v(acc[ai][bj][m][0] * rs, acc[ai][bj][m][1] * rs); }
    }
};
struct EpiWo {
    static constexpr bool PERM = true;
    const float* x; float* H1; bf16_t* XB;
    __device__ __forceinline__ void operator()(const Acc& acc, const Unit& u, int wr, int wc, int fr, int fq) const {
        const int row0 = u.pm * 256 + wr * 64 + fr, col0 = u.pn * 256 + wc * 32 + 8 * fq;
#pragma unroll
        for (int ai = 0; ai < 2; ++ai)
#pragma unroll
            for (int m = 0; m < 4; ++m) { const size_t off = (size_t)(row0 + ai * 128 + m * 16) * DM + col0;
#pragma unroll
                for (int bj = 0; bj < 2; ++bj) { const f32x4 a = *(const f32x4*)(x + off + bj * 128) + acc[ai][bj][m][0], b = *(const f32x4*)(x + off + bj * 128 + 4) + acc[ai][bj][m][1];
                    *(f32x4*)(H1 + off + bj * 128) = a; *(f32x4*)(H1 + off + bj * 128 + 4) = b; *(u32x4*)(XB + off + bj * 128) = pack8v(a, b); }
                if (m & 1) asm volatile("" ::: "memory"); }
    }
};
__device__ __forceinline__ float swiglu1(float g, float u) {
    g = fminf(g, 7.f); u = fminf(fmaxf(u, -7.f), 7.f);
    const float sg = __builtin_amdgcn_rcpf(1.f + __builtin_amdgcn_exp2f(-1.702f * 1.4426950408889634f * g));
    return g * sg * (u + 1.f);
}
struct EpiGU {
    static constexpr bool PERM = true;
    bf16_t* H; const float* bgu; const float* listr; const LAS int* tstart;
    __device__ __forceinline__ void operator()(const Acc& acc, const Unit& u, int wr, int wc, int fr, int fq) const {
        const int lr0 = (u.pm - tstart[u.e]) * 256 + wr * 64 + fr, f0 = u.pn * 128 + wc * 32 + 8 * fq;
        const float* bg = bgu + (size_t)u.e * 4096 + f0; const f32x4 bg0 = *(const f32x4*)bg, bg1 = *(const f32x4*)(bg + 4), bu0 = *(const f32x4*)(bg + 2048), bu1 = *(const f32x4*)(bg + 2052);
#pragma unroll
        for (int ai = 0; ai < 2; ++ai)
#pragma unroll
            for (int m = 0; m < 4; ++m) { const int lr = lr0 + ai * 128 + m * 16; const float rs = listr[(size_t)u.e * LIST_CAP + lr];
                const f32x4 g0 = acc[ai][0][m][0] * rs + bg0, g1 = acc[ai][0][m][1] * rs + bg1, u0 = acc[ai][1][m][0] * rs + bu0, u1 = acc[ai][1][m][1] * rs + bu1;
                f32x4 h0, h1;
#pragma unroll
                for (int j = 0; j < 4; ++j) { h0[j] = swiglu1(g0[j], u0[j]); h1[j] = swiglu1(g1[j], u1[j]); }
                *(u32x4*)(H + (size_t)(u.pm * 256 + wr * 64 + fr + ai * 128 + m * 16) * DM + f0) = pack8v(h0, h1); }
    }
};
struct EpiDn {
    static constexpr bool PERM = true;
    bf16_t* Y; const float* bdn;
    __device__ __forceinline__ void operator()(const Acc& acc, const Unit& u, int wr, int wc, int fr, int fq) const {
        const int row0 = u.pm * 256 + wr * 64 + fr, col0 = u.pn * 256 + wc * 32 + 8 * fq;
        f32x4 bv[2][2];
#pragma unroll
        for (int bj = 0; bj < 2; ++bj)
#pragma unroll
            for (int n = 0; n < 2; ++n) bv[bj][n] = *(const f32x4*)(bdn + (size_t)u.e * DM + col0 + bj * 128 + 4 * n);
#pragma unroll
        for (int ai = 0; ai < 2; ++ai)
#pragma unroll
            for (int m = 0; m < 4; ++m) { bf16_t* rowp = Y + (size_t)(row0 + ai * 128 + m * 16) * DM + col0;
#pragma unroll
                for (int bj = 0; bj < 2; ++bj) *(u32x4*)(rowp + bj * 128) = pack8v(acc[ai][bj][m][0] + bv[bj][0], acc[ai][bj][m][1] + bv[bj][1]); }
    }
};

__device__ __forceinline__ void p2_cumsum(Frame& F, const Args& a) {
    if (F.wave != 0) return;
    const float* FL = (const float*)(F.ws + WS_FL); float* NC = (float*)(F.ws + WS_CUM); const float* b_forget = a.in[7];
    for (int sq = F.vcu; sq < NB * 8; sq += F.G) {
        const int b = sq >> 3, h = sq & 7; const float bf = b_forget[h];
        const float* src = FL + ((size_t)b * SEQ + (size_t)F.lane * 128) * 8 + h;
        double run = 0.0;
        for (int i = 0; i < 128; i += 8) { float v[8];
#pragma unroll
            for (int j = 0; j < 8; ++j) v[j] = src[(size_t)(i + j) * 8];
#pragma unroll
            for (int j = 0; j < 8; ++j) { const float xx = v[j] + bf; run += (double)(fminf(xx, 0.f) - __logf(1.f + __expf(-fabsf(xx)))); } }
        double incl = run;
#pragma unroll
        for (int o = 1; o < 64; o <<= 1) { const double up = __shfl_up(incl, o); if (F.lane >= o) incl += up; }
        double acc = incl - run;
        float* dst = NC + (size_t)sq * SEQ + (size_t)F.lane * 128;
        for (int i = 0; i < 128; i += 8) { float v[8];
#pragma unroll
            for (int j = 0; j < 8; ++j) v[j] = src[(size_t)(i + j) * 8];
#pragma unroll
            for (int j = 0; j < 8; ++j) { const float xx = v[j] + bf; acc += (double)(fminf(xx, 0.f) - __logf(1.f + __expf(-fabsf(xx)))); dst[i + j] = (float)(-11.313708498984761 * acc); } }
    }
}

template <int DK, bool BIAS, int LDQ, int LDK, int LDV>
__device__ __forceinline__ void attn_group(Frame& F, char* lds, const bf16_t* Qb, int qhs, const bf16_t* Kb, const bf16_t* Vb, int khs, const bf16_t* KRb, const float* NCb, bf16_t* Ob) {
    const int nquad = (256 - F.vcu + F.G - 1) / F.G; if (nquad <= 0) return;
    const int nblk = nquad * 4;
    auto ref = [&](int i) { att::BlockRef R; const int quad = F.vcu + (i >> 2) * F.G, bh = quad >> 3, s = quad & 7, b = bh >> 3, h = bh & 7, j = i & 3;
        const int qb = (j == 0) ? s : (j == 1) ? 15 - s : (j == 2) ? 16 + s : 31 - s; const size_t tok0 = (size_t)b * SEQ + (size_t)qb * 256;
        R.Q = Qb + tok0 * LDQ + h * qhs; R.K = Kb + (size_t)b * SEQ * LDK + h * khs; R.V = Vb + (size_t)b * SEQ * LDV + h * khs;
        R.KR = KRb + (size_t)b * SEQ * 64; R.NC = NCb + (size_t)bh * SEQ; R.O = Ob + tok0 * att::LDO + h * 128; R.P0 = qb * 256; return R; };
    att::Seam<DK> S;
    att::BlockRef cur = ref(0);
    att::prime<DK, BIAS, LDQ, LDK, LDV>(cur, lds, S);
    for (int i = 0; i < nblk; ++i) {
        const att::BlockRef nxt = (i + 1 < nblk) ? ref(i + 1) : cur;
        att::block<DK, BIAS, LDQ, LDK, LDV>(cur, nxt, lds, S);
        cur = nxt;
    }
    VM_WAIT(); __syncthreads();
}

__device__ __forceinline__ void p4_onorm(Frame& F) {
    bf16_t* O = (bf16_t*)(F.ws + WS_O); const int gw = F.vcu * NWAVES + F.wave, NGW = F.G * NWAVES;
    for (int m = gw; m < T; m += NGW) {
        GAS u32x4* p = (GAS u32x4*)(O + (size_t)m * DM) + F.lane; u32x4 w[4]; float ss[2] = {0.f, 0.f};
#pragma unroll
        for (int j = 0; j < 4; ++j) { w[j] = p[64 * j]; float s = 0.f;
#pragma unroll
            for (int q = 0; q < 4; ++q) { const float lo = bf_lo(w[j][q]), hi = bf_hi(w[j][q]); s += lo * lo + hi * hi; }
            ss[j >> 1] += s; }
        const float r0 = 1.f / sqrtf(wave_sum(ss[0]) * (1.f / 1024.f) + EPS), r1 = 1.f / sqrtf(wave_sum(ss[1]) * (1.f / 1024.f) + EPS);
#pragma unroll
        for (int j = 0; j < 4; ++j) { const float rs = (j < 2) ? r0 : r1; u32x4 o;
#pragma unroll
            for (int q = 0; q < 4; ++q) o[q] = cvt_pk_bf16(bf_lo(w[j][q]) * rs, bf_hi(w[j][q]) * rs);
            p[64 * j] = o; }
    }
}

__device__ __forceinline__ void p6_router(Frame& F, const Args& a) {
    const float* H1 = a.out; const float* WR = (const float*)(F.ws + WS_WR); const float* b_router = a.in[13];
    int* RE = (int*)(F.ws + WS_RE); int* RP = (int*)(F.ws + WS_RP); float* RG = (float*)(F.ws + WS_RG); int* LIST = (int*)(F.ws + WS_LIST); float* LISTR = (float*)(F.ws + WS_LISTR);
    gu32* cnt = F.ctl + CW_CNT;
    LAS float* part = (LAS float*)F.lds;
    LAS float* ssqp = (LAS float*)(F.lds + 8 * 32 * 33 * 4);
    LAS int* lcnt = (LAS int*)(F.lds + 8 * 32 * 33 * 4 + 2048);
    LAS int* lbase = lcnt + 32;
    const int w = F.wave, r = F.lane & 31, hh = F.lane >> 5;
    float bw[128];
#pragma unroll
    for (int j = 0; j < 32; ++j)
#pragma unroll
        for (int i = 0; i < 4; ++i) bw[j * 4 + i] = WR[(size_t)(256 * w + 8 * j + 4 * hh + i) * 32 + r];
    if (F.tid < 32) lcnt[F.tid] = 0;
    __syncthreads();
    for (int tile = F.vcu; tile < T / 32; tile += F.G) {
        const int tok0 = tile * 32;
        const float* xr = H1 + (size_t)(tok0 + r) * DM + 256 * w + 4 * hh;
        f32x16 acc = {}; float ssq = 0.f;
#pragma unroll
        for (int jb = 0; jb < 4; ++jb) { f32x4 av[8];
#pragma unroll
            for (int jj = 0; jj < 8; ++jj) av[jj] = *(const f32x4*)(xr + 8 * (8 * jb + jj));
#pragma unroll
            for (int jj = 0; jj < 8; ++jj)
#pragma unroll
                for (int i = 0; i < 4; ++i) { acc = __builtin_amdgcn_mfma_f32_32x32x2f32(av[jj][i], bw[(8 * jb + jj) * 4 + i], acc, 0, 0, 0); ssq += av[jj][i] * av[jj][i]; } }
#pragma unroll
        for (int q = 0; q < 16; ++q) part[(w * 32 + ((q & 3) + 8 * (q >> 2) + 4 * hh)) * 33 + r] = acc[q];
        ssqp[(w * 2 + hh) * 32 + r] = ssq;
        __syncthreads();
        int my_e[2] = {0, 0}, my_rank[2] = {0, 0}; float my_g[2] = {0.f, 0.f}, my_rs[2] = {0.f, 0.f};
#pragma unroll
        for (int ps = 0; ps < 2; ++ps) {
            const int tl = 4 * w + 2 * ps + hh;
            float s = 0.f, lg = 0.f;
#pragma unroll
            for (int ww = 0; ww < 8; ++ww) { lg += part[(ww * 32 + tl) * 33 + r]; s += ssqp[(ww * 2 + 0) * 32 + tl] + ssqp[(ww * 2 + 1) * 32 + tl]; }
            const float rs = 1.f / sqrtf(s * (1.f / DM) + EPS);
            lg = lg * rs + b_router[r];
            float tv[4]; int ti[4]; float cur = lg;
#pragma unroll
            for (int k = 0; k < 4; ++k) { float bv = cur; int bi = r;
#pragma unroll
                for (int o = 1; o < 32; o <<= 1) { const float ov = __shfl_xor(bv, o); const int oi = __shfl_xor(bi, o); if (ov > bv || (ov == bv && oi < bi)) { bv = ov; bi = oi; } }
                tv[k] = bv; ti[k] = bi; if (r == bi) cur = -__builtin_inff(); }
            const float e1 = __expf(tv[1] - tv[0]), e2 = __expf(tv[2] - tv[0]), e3 = __expf(tv[3] - tv[0]); const float inv = 1.f / (1.f + e1 + e2 + e3);
            if (r < 4) { my_e[ps] = ti[r]; my_g[ps] = (r == 0 ? 1.f : r == 1 ? e1 : r == 2 ? e2 : e3) * inv; my_rs[ps] = rs;
                my_rank[ps] = __hip_atomic_fetch_add(lcnt + ti[r], 1, __ATOMIC_RELAXED, __HIP_MEMORY_SCOPE_WORKGROUP); }
        }
        __syncthreads();
        if (F.tid < 32) { const int n = lcnt[F.tid]; lbase[F.tid] = n ? (int)__hip_atomic_fetch_add(cnt + 64 * F.tid, (unsigned)n, RLX_AGENT) : 0; lcnt[F.tid] = 0; }
        __syncthreads();
        if (r < 4) {
#pragma unroll
            for (int ps = 0; ps < 2; ++ps) { const int t = tok0 + 4 * w + 2 * ps + hh, e = my_e[ps], pos = lbase[e] + my_rank[ps];
                RE[t * 4 + r] = e; RP[t * 4 + r] = pos; RG[t * 4 + r] = my_g[ps];
                LIST[(size_t)e * LIST_CAP + pos] = t; LISTR[(size_t)e * LIST_CAP + pos] = my_rs[ps]; }
        }
        __syncthreads();
    }
}

__device__ __forceinline__ void moe_tables(Frame& F) {
    LAS int* tstart = (LAS int*)(F.lds + TAB_OFF);
    if (F.tid == 0) { int acc = 0;
        for (int e = 0; e < NE; ++e) { tstart[e] = acc; const int n = (int)__hip_atomic_load(F.ctl + CW_CNT + 64 * e, RLX_AGENT); acc += (n + 255) >> 8; }
        tstart[NE] = acc; }
    __syncthreads();
}

__device__ __forceinline__ void p9_final(Frame& F, const Args& a) {
    const LAS int* tstart = (const LAS int*)(F.lds + TAB_OFF);
    const int* RE = (const int*)(F.ws + WS_RE); const int* RP = (const int*)(F.ws + WS_RP); const float* RG = (const float*)(F.ws + WS_RG);
    const bf16_t* YK = (const bf16_t*)(F.ws + WS_YK); const float* g_final = a.in[18]; float* out = a.out;
    const int gw = F.vcu * NWAVES + F.wave, NGW = F.G * NWAVES;
    for (int m = gw; m < T; m += NGW) {
        const GAS u32x4* yp[4]; float gk[4];
#pragma unroll
        for (int k = 0; k < 4; ++k) { const int e = RE[m * 4 + k], pos = RP[m * 4 + k]; gk[k] = RG[m * 4 + k];
            yp[k] = (const GAS u32x4*)(YK + (size_t)(tstart[e] * 256 + pos) * DM) + F.lane; }
        GAS f32x4* xr = (GAS f32x4*)(out + (size_t)m * DM);
        f32x4 y[8]; float s = 0.f;
#pragma unroll
        for (int j = 0; j < 4; ++j) {
            f32x4 a0 = xr[(64 * j + F.lane) * 2], a1 = xr[(64 * j + F.lane) * 2 + 1];
#pragma unroll
            for (int k = 0; k < 4; ++k) { const u32x4 wv = yp[k][64 * j];
                a0 += gk[k] * (f32x4){bf_lo(wv.x), bf_hi(wv.x), bf_lo(wv.y), bf_hi(wv.y)}; a1 += gk[k] * (f32x4){bf_lo(wv.z), bf_hi(wv.z), bf_lo(wv.w), bf_hi(wv.w)}; }
            y[2 * j] = a0; y[2 * j + 1] = a1;
            s += (a0.x * a0.x + a0.y * a0.y) + (a0.z * a0.z + a0.w * a0.w) + (a1.x * a1.x + a1.y * a1.y) + (a1.z * a1.z + a1.w * a1.w); }
        const float rstd = 1.f / sqrtf(wave_sum(s) * (1.f / DM) + EPS);
#pragma unroll
        for (int j = 0; j < 4; ++j) { const f32x4 g0 = *((const GAS f32x4*)g_final + (64 * j + F.lane) * 2), g1 = *((const GAS f32x4*)g_final + (64 * j + F.lane) * 2 + 1);
            xr[(64 * j + F.lane) * 2] = y[2 * j] * rstd * g0; xr[(64 * j + F.lane) * 2 + 1] = y[2 * j + 1] * rstd * g1; }
    }
}
__device__ __forceinline__ void dbg_final_norm(Frame& F, const Args& a, const float* src) {
    const float* g_final = a.in[18]; float* out = a.out; const int gw = F.vcu * NWAVES + F.wave, NGW = F.G * NWAVES;
    for (int m = gw; m < T; m += NGW) {
        const GAS f32x4* xr = (const GAS f32x4*)(src + (size_t)m * DM) + F.lane; GAS f32x4* orow = (GAS f32x4*)(out + (size_t)m * DM) + F.lane;
        f32x4 v[8]; float s = 0.f;
#pragma unroll
        for (int j = 0; j < 8; ++j) { v[j] = xr[64 * j]; s += (v[j].x * v[j].x + v[j].y * v[j].y) + (v[j].z * v[j].z + v[j].w * v[j].w); }
        const float rstd = 1.f / sqrtf(wave_sum(s) * (1.f / DM) + EPS);
#pragma unroll
        for (int j = 0; j < 8; ++j) orow[64 * j] = v[j] * rstd * *((const GAS f32x4*)g_final + 64 * j + F.lane);
    }
}

__global__ void __launch_bounds__(NWAVES * 64, 2) mk_fwd(Args args) {
    extern __shared__ __attribute__((aligned(16))) unsigned char lds[];
    Frame F;
    F.lds = (LAS unsigned char*)lds; F.MISC = (volatile LAS unsigned*)(F.lds + MISC_OFF);
    F.tid = threadIdx.x; F.lane = F.tid & 63; F.wave = __builtin_amdgcn_readfirstlane(F.tid >> 6);
    F.G = gridDim.x; { const int bx = blockIdx.x; F.vcu = (F.G % 8 == 0) ? (bx % 8) * (F.G / 8) + bx / 8 : bx; }
    F.ws = args.ws; F.ctl = (gu32*)(args.ws + WS_CTL);
    for (int u = F.tid; u < (LDS_BYTES - LDSCTL_OFF) / 4; u += NWAVES * 64) ((LAS unsigned*)(F.lds + LDSCTL_OFF))[u] = 0u;
    __syncthreads();
    XcdBarrier bar; bar.bar = (unsigned*)(F.ctl + CW_BAR); bar.x = 0; bar.st = nullptr;
#if MK_ONE_LAUNCH
    bar = xcd_barrier_post((unsigned*)(F.ctl + CW_BAR), F.MISC + 8);
#define GRID_BAR() xcd_barrier(bar)
#else
#define GRID_BAR() do { } while (0)
#endif
    const int lo = args.ph_lo, hi = args.ph_hi;
#ifndef MK_PHASE_MASK
#define MK_PHASE_MASK 0xffffffffu
#endif
#define IN(k) (((MK_PHASE_MASK >> (k)) & 1u) && lo <= (k) && (k) < hi)
#define BOTH(k) (IN(k) && IN((k) + 1))
    unsigned char* ws = args.ws;
    bf16_t* PROJ = (bf16_t*)(ws + WS_PROJ); float* ssq = (float*)(ws + WS_SSQ); const f32x2* rope = (const f32x2*)(ws + WS_ROPE);
    LAS int* tstart = (LAS int*)(F.lds + TAB_OFF);

    if (IN(0)) { p0_prologue(F, args); if (BOTH(0)) GRID_BAR(); }
    if (IN(1)) {
        pg8::DenseSched S; S.o.init(T / 256, 17, F.G, (int)blockIdx.x); S.A = (const bf16_t*)(ws + WS_HN); S.Bt = (const bf16_t*)(ws + WS_WIN); S.lda = DM; S.ldb = DM;
        EpiP1 E{PROJ, (bf16_t*)(ws + WS_KR), (float*)(ws + WS_FL), ssq, rope};
        pg8::gemm_phase<EpiP1, pg8::DenseSched, false>(F.lds, DM, S, E);
        if (BOTH(1)) GRID_BAR();
    }
    if (IN(2)) {
        p2_cumsum(F, args); __syncthreads();
        { pg8::DenseSched S; S.o.init(T / 256, QW / 256, F.G, (int)blockIdx.x); S.A = PROJ; S.Bt = (const bf16_t*)(ws + WS_WQB); S.lda = PW; S.ldb = 512;
          EpiQ E{(bf16_t*)(ws + WS_QB), ssq, rope};
          pg8::gemm_phase<EpiQ, pg8::DenseSched, false>(F.lds, 512, S, E); }
        { pg8::DenseSched S; S.o.init(T / 256, KVW / 256, F.G, (int)blockIdx.x); S.A = PROJ + 512; S.Bt = (const bf16_t*)(ws + WS_WKVB); S.lda = PW; S.ldb = 512;
          EpiKV E{(bf16_t*)(ws + WS_KV), ssq + T};
          pg8::gemm_phase<EpiKV, pg8::DenseSched, false>(F.lds, 512, S, E); }
        if (BOTH(2)) GRID_BAR();
    }
    if (IN(3)) {
        const bf16_t* KV = (const bf16_t*)(ws + WS_KV); bf16_t* O = (bf16_t*)(ws + WS_O);
#ifndef MK_NO_MLA
        attn_group<192, false, QW, KVW, KVW>(F, (char*)lds, (const bf16_t*)(ws + WS_QB), 192, KV, KV + 128, 256, (const bf16_t*)(ws + WS_KR), nullptr, O);
#endif
#ifndef MK_NO_FOX
        attn_group<128, true, PW, PW, PW>(F, (char*)lds, PROJ + 1024, 128, PROJ + 2048, PROJ + 3072, 128, nullptr, (const float*)(ws + WS_CUM), O + 1024);
#endif
        if (BOTH(3)) GRID_BAR();
    }
    if (IN(4)) { p4_onorm(F); if (BOTH(4)) GRID_BAR(); }
    if (IN(5)) {
        pg8::DenseSched S; S.o.init(T / 256, DM / 256, F.G, (int)blockIdx.x); S.A = (const bf16_t*)(ws + WS_O); S.Bt = (const bf16_t*)(ws + WS_WO); S.lda = DM; S.ldb = DM;
        EpiWo E{args.in[0], args.out, (bf16_t*)(ws + WS_XB)};
        pg8::gemm_phase<EpiWo, pg8::DenseSched, false>(F.lds, DM, S, E);
        if (BOTH(5)) GRID_BAR();
    }
    if (IN(6)) { p6_router(F, args); if (BOTH(6)) GRID_BAR(); }
    if (IN(7)) {
        moe_tables(F);
        pg8::MoeSched S; S.o.init(tstart[NE], 16, F.G, (int)blockIdx.x); S.A = (const bf16_t*)(ws + WS_XB); S.Bt = (const bf16_t*)(ws + WS_WGU); S.lda = DM; S.ldb = DM; S.nBrows = 4096;
        S.tstart = tstart; S.list = (const int*)(ws + WS_LIST); S.cnt = F.ctl + CW_CNT; S.gather = true;
        EpiGU E{(bf16_t*)(ws + WS_H), args.in[15], (const float*)(ws + WS_LISTR), tstart};
        pg8::gemm_phase<EpiGU, pg8::MoeSched, true>(F.lds, DM, S, E);
        if (BOTH(7)) GRID_BAR();
    }
    if (IN(8)) {
        moe_tables(F);
        pg8::MoeSched S; S.o.init(tstart[NE], 8, F.G, (int)blockIdx.x); S.A = (const bf16_t*)(ws + WS_H); S.Bt = (const bf16_t*)(ws + WS_WDN); S.lda = DM; S.ldb = DM; S.nBrows = DM;
        S.tstart = tstart; S.list = (const int*)(ws + WS_LIST); S.cnt = F.ctl + CW_CNT; S.gather = false;
        EpiDn E{(bf16_t*)(ws + WS_YK), args.in[17]};
        pg8::gemm_phase<EpiDn, pg8::MoeSched, false>(F.lds, DM, S, E);
        if (BOTH(8)) GRID_BAR();
    }
    if (IN(9)) { moe_tables(F); p9_final(F, args); }
    if (IN(20)) dbg_final_norm(F, args, args.in[0]);
    if (IN(21)) dbg_final_norm(F, args, args.out);
#undef IN
#undef BOTH
}

extern "C" void kernel_launch(void* const* d_in, const int* in_sizes, int n_in, void* d_out, int out_size, void* d_ws, size_t ws_size, hipStream_t stream) {
    static int grid = 0;
    if (grid == 0) {
        if (n_in != 19 || in_sizes[0] != T * DM || out_size != T * DM || ws_size < WS_END) {
            fprintf(stderr, "kernel_launch: unexpected shapes (n_in %d, in0 %d, out %d, ws %zu < %zu); nothing launched\n", n_in, n_in > 0 ? in_sizes[0] : -1, out_size, ws_size, (size_t)WS_END); grid = -1; return; }
        int dev = 0, cus = 0, per_cu = 0;
        if (hipGetDevice(&dev) != hipSuccess || hipDeviceGetAttribute(&cus, hipDeviceAttributeMultiprocessorCount, dev) != hipSuccess) { grid = -1; return; }
        if (hipFuncSetAttribute((const void*)mk_fwd, hipFuncAttributeMaxDynamicSharedMemorySize, LDS_BYTES) != hipSuccess) { fprintf(stderr, "kernel_launch: hipFuncSetAttribute failed\n"); grid = -1; return; }
        if (hipOccupancyMaxActiveBlocksPerMultiprocessor(&per_cu, (const void*)mk_fwd, NWAVES * 64, LDS_BYTES) != hipSuccess || per_cu < 1)
            fprintf(stderr, "kernel_launch: note: occupancy query reports %d workgroups per CU\n", per_cu);
        (void)hipGetLastError();
        grid = cus;
    }
    if (grid < 0) return;
    if (hipMemsetAsync((char*)d_ws + WS_CTL, 0, CTL_ZERO_BYTES, stream) != hipSuccess) return;
    Args a{};
    for (int i = 0; i < 19; ++i) a.in[i] = (const float*)d_in[i];
    a.out = (float*)d_out; a.ws = (unsigned char*)d_ws;
#if MK_ONE_LAUNCH
    a.ph_lo = 0; a.ph_hi = MK_PH_END;
    hipLaunchKernelGGL(mk_fwd, dim3(grid), dim3(NWAVES * 64), LDS_BYTES, stream, a);
#else
    for (int p = 0; p < MK_PH_END; ++p) { a.ph_lo = p; a.ph_hi = p + 1; hipLaunchKernelGGL(mk_fwd, dim3(grid), dim3(NWAVES * 64), LDS_BYTES, stream, a); }
#endif
#ifdef MK_DBG_PHASE
    a.ph_lo = MK_DBG_PHASE; a.ph_hi = MK_DBG_PHASE + 1; hipLaunchKernelGGL(mk_fwd, dim3(grid), dim3(NWAVES * 64), LDS_BYTES, stream, a);
#endif
}
```

```cpp
#include <hip/hip_runtime.h>
#include <cstdio>
#include <cstdint>

#ifndef MK_FP8
#define MK_FP8 1
#endif
constexpr bool USE_FP8 = MK_FP8;
#ifndef MK_FP8D
#define MK_FP8D 0
#endif
constexpr bool FP8D = MK_FP8D;
#ifndef MK_FP8O
#define MK_FP8O 0
#endif
constexpr bool FP8O = MK_FP8O;
#ifndef MK_DUP
#define MK_DUP -1
#endif
#ifndef MK_ONE_LAUNCH
#define MK_ONE_LAUNCH 1
#endif
#ifndef MK_PH_END
#define MK_PH_END 10
#endif

#define LAS __attribute__((address_space(3)))
#define GAS __attribute__((address_space(1)))
typedef unsigned short bf16_t;
typedef short bf16x8 __attribute__((ext_vector_type(8)));
typedef short s16x4 __attribute__((ext_vector_type(4)));
typedef float f32x2 __attribute__((ext_vector_type(2)));
typedef float f32x4 __attribute__((ext_vector_type(4)));
typedef float f32x16 __attribute__((ext_vector_type(16)));
typedef unsigned u32x2 __attribute__((ext_vector_type(2)));
typedef unsigned u32x4 __attribute__((ext_vector_type(4)));
typedef int i32x2 __attribute__((ext_vector_type(2)));
typedef int i32x4 __attribute__((ext_vector_type(4)));
typedef int i32x8 __attribute__((ext_vector_type(8)));

constexpr int NB = 4, SEQ = 8192, T = NB * SEQ, DM = 2048;
constexpr int NIN = 4168;
constexpr int PW = 4096;
constexpr int NE = 32, TOPK = 4;
constexpr int QW = 1536, KVW = 2048;
constexpr float EPS = 1e-5f;
constexpr int LIST_CAP = T;
constexpr int MAX_RT = 544;

constexpr size_t MiB = 1u << 20;
constexpr size_t WS_CTL = 0, CTL_ZERO_BYTES = 2 * MiB;
constexpr size_t WS_SSQ = 2772 * MiB;
constexpr size_t WS_ROPE = 2 * MiB;
constexpr size_t WS_WR = 4 * MiB;
constexpr size_t WS_FL = 5 * MiB;
constexpr size_t WS_CUM = 6 * MiB;
constexpr size_t WS_KR = 7 * MiB;
constexpr size_t WS_RE = 11 * MiB, WS_RP = WS_RE + 512 * 1024, WS_RG = WS_RP + 512 * 1024;
constexpr size_t WS_LIST = 13 * MiB;
constexpr size_t WS_LISTR = 17 * MiB;
constexpr size_t WS_WIN = 22 * MiB;
constexpr size_t WS_WQB = 39 * MiB;
constexpr size_t WS_WKVB = 41 * MiB;
constexpr size_t WS_WO = 43 * MiB;
constexpr size_t WS_WGU = 52 * MiB;
constexpr size_t WS_WDN = 564 * MiB;
constexpr size_t WS_HN = 820 * MiB;
constexpr size_t WS_PROJ = 948 * MiB;
constexpr size_t WS_QB = 1204 * MiB;
constexpr size_t WS_KV = 1300 * MiB;
constexpr size_t WS_O = 1428 * MiB;
constexpr size_t WS_XB = 1556 * MiB;
constexpr size_t WS_H = 1684 * MiB;
constexpr size_t WS_YK = 2228 * MiB;
constexpr size_t WS_SS = 2774 * MiB;
constexpr size_t WS_RR = 2776 * MiB;
constexpr size_t WS_K8 = 2777 * MiB;
constexpr size_t WS_KR8 = 2809 * MiB;
constexpr size_t WS_NRMP = 2811 * MiB;
constexpr size_t WS_END = 2819 * MiB;
constexpr int CW_TMO = 0, CW_CODE = 1;
constexpr int CW_BAR = 4096;
constexpr int CW_NRM = 12288;
constexpr int CW_CNT = 16384;

constexpr int RING_BYTES = 147456;
constexpr int LDSCTL_OFF = RING_BYTES, MISC_OFF = LDSCTL_OFF + 320;
constexpr int TAB_OFF = LDSCTL_OFF + 1024;
constexpr int LDS_BYTES = 151552;
constexpr int UTAB_OFF = LDSCTL_OFF + 2048;
constexpr int NWAVES = 8;

#define RLX_AGENT __ATOMIC_RELAXED, __HIP_MEMORY_SCOPE_AGENT
#define LDS_WAIT() asm volatile("s_waitcnt lgkmcnt(0)" ::: "memory")
#define VM_WAIT() asm volatile("s_waitcnt vmcnt(0)" ::: "memory")
typedef GAS unsigned gu32;

__device__ __forceinline__ unsigned f2bf(float f) { unsigned u = __builtin_bit_cast(unsigned, f); return (u + 0x7fffu + ((u >> 16) & 1u)) >> 16; }
__device__ __forceinline__ unsigned pk2(float lo, float hi) { return f2bf(lo) | (f2bf(hi) << 16); }
__device__ __forceinline__ unsigned cvt_pk_bf16(float lo, float hi) { unsigned r; asm volatile("v_cvt_pk_bf16_f32 %0, %1, %2" : "=v"(r) : "v"(lo), "v"(hi)); return r; }
__device__ __forceinline__ u32x2 pack8f8(f32x4 a, f32x4 b) {
    unsigned lo = 0u, hi = 0u; lo = __builtin_amdgcn_cvt_pk_fp8_f32(a[0], a[1], lo, false); lo = __builtin_amdgcn_cvt_pk_fp8_f32(a[2], a[3], lo, true);
    hi = __builtin_amdgcn_cvt_pk_fp8_f32(b[0], b[1], hi, false); hi = __builtin_amdgcn_cvt_pk_fp8_f32(b[2], b[3], hi, true); return (u32x2){lo, hi}; }
__device__ __forceinline__ float bf_lo(unsigned w) { return __builtin_bit_cast(float, w << 16); }
__device__ __forceinline__ float bf_hi(unsigned w) { return __builtin_bit_cast(float, w & 0xffff0000u); }
__device__ __forceinline__ float wave_sum(float v) {
#pragma unroll
    for (int o = 1; o < 64; o <<= 1) v += __shfl_xor(v, o);
    return v;
}

#define XB_TMO      128
#define XB_XCNT(j)  (256  + 64 * (j))
#define XB_XSUB(j)  (1280 + 64 * (j))
#define XB_XGEN(j)  (2304 + 64 * (j))
#define XB_TOP      3328
#define XB_TOPGEN   3392
#define XCD_BAR_WORDS 3456
#define XB_SPIN_CAP (1u << 18)

__device__ __forceinline__ unsigned xb_ld(unsigned* p)              { return __hip_atomic_load(p, __ATOMIC_RELAXED, __HIP_MEMORY_SCOPE_AGENT); }
__device__ __forceinline__ unsigned xb_add(unsigned* p, unsigned v) { return __hip_atomic_fetch_add(p, v, __ATOMIC_RELAXED, __HIP_MEMORY_SCOPE_AGENT); }
__device__ __forceinline__ unsigned xb_xcc_id() { return (unsigned)__builtin_amdgcn_s_getreg((3 << 11) | 20) & 0xFu; }
#define XB_SPIN(cond, bar) do { unsigned _sp = 0; while (cond) { __builtin_amdgcn_s_sleep(1); \
    if ((++_sp & 255u) == 0u) { if (xb_ld(&(bar)[XB_TMO])) break; if (_sp > XB_SPIN_CAP) { atomicAdd(&(bar)[XB_TMO], 1u); break; } } } } while (0)

struct XcdBarrier { unsigned* bar; unsigned x; volatile LAS unsigned* st; };

__device__ __forceinline__ XcdBarrier xcd_barrier_post(unsigned* bar, volatile LAS unsigned* st) {
    XcdBarrier b; b.bar = bar; b.x = xb_xcc_id(); b.st = st;
    if (threadIdx.x == 0) (void)xb_add(&bar[XB_XCNT(b.x)], 1u);
    return b;
}
__device__ __forceinline__ void xcd_barrier_complete(unsigned* bar, unsigned x, unsigned& nloc, unsigned& nx) {
    const unsigned G = gridDim.x * gridDim.y * gridDim.z;
    unsigned sum, cnt, mine, sp = 0u;
    for (;;) {
        sum = 0u; cnt = 0u; mine = 0u;
#pragma unroll
        for (unsigned j = 0; j < 16; ++j) { const unsigned c = xb_ld(&bar[XB_XCNT(j)]); sum += c; cnt += (c > 0u) ? 1u : 0u; mine = (j == x) ? c : mine; }
        if (sum == G) break;
        __builtin_amdgcn_s_sleep(1);
        if ((++sp & 255u) == 0u) { if (xb_ld(&bar[XB_TMO])) break; if (sp > XB_SPIN_CAP) { atomicAdd(&bar[XB_TMO], 1u); break; } }
    }
    nloc = mine > 0u ? mine : 1u; nx = cnt > 0u ? cnt : 1u;
}
__device__ __forceinline__ void xcd_barrier(const XcdBarrier& b) {
    asm volatile("s_waitcnt vmcnt(0)" ::: "memory");
    __syncthreads();
    if (threadIdx.x == 0) {
        unsigned* bar = b.bar;
        __builtin_amdgcn_s_waitcnt(0);
        unsigned nloc = b.st[0], nx = b.st[1];
        if (nloc == 0u) { xcd_barrier_complete(bar, b.x, nloc, nx); b.st[0] = nloc; b.st[1] = nx; }
        const unsigned old = xb_add(&bar[XB_XSUB(b.x)], 1u);
        const unsigned gen = old / nloc;
        if (old + 1u == (gen + 1u) * nloc) {
            __builtin_amdgcn_fence(__ATOMIC_RELEASE, "agent");
            asm volatile("s_waitcnt vmcnt(0)" ::: "memory");
            const unsigned og = xb_add(&bar[XB_TOP], 1u);
            const unsigned tg = og / nx;
            if (og + 1u == (tg + 1u) * nx) xb_add(&bar[XB_TOPGEN], 1u);
            else XB_SPIN(xb_ld(&bar[XB_TOPGEN]) == tg, bar);
            __builtin_amdgcn_fence(__ATOMIC_ACQUIRE, "agent");
            xb_add(&bar[XB_XGEN(b.x)], 1u);
            asm volatile("s_waitcnt vmcnt(0)" ::: "memory");
        } else {
            XB_SPIN(xb_ld(&bar[XB_XGEN(b.x)]) == gen, bar);
            __builtin_amdgcn_fence(__ATOMIC_ACQUIRE, "agent");
            asm volatile("s_waitcnt vmcnt(0)" ::: "memory");
        }
    }
    __syncthreads();
}

namespace pg8 {
constexpr int BM = 256, BK = 64, HALF = 128, HTB = HALF * BK * 2, STAGE_BYTES = 8 * HTB, NXCD = 8, WGM = 8;
__host__ __device__ __forceinline__ int lds_byte(int r, int c) { const int st = (r >> 4) * 2 + (c >> 5), rr = r & 15, cc = c & 31, ob = rr * 64 + cc * 2; return st * 1024 + (ob ^ (((ob >> 9) & 1) << 5)); }
__host__ __device__ __forceinline__ void stage_rc(int b, int& R, int& C) { const int st = b / 1024, sb = b % 1024, swz = sb ^ (((sb >> 9) & 1) << 5); R = (st >> 1) * 16 + swz / 64; C = (st & 1) * 32 + (swz % 64) / 2; }
__host__ __device__ __forceinline__ int perm32(int rho) { const int n = rho >> 4, i = rho & 15; return 8 * (i >> 2) + 4 * n + (i & 3); }

__device__ __forceinline__ const char* uni(const char* p) {
    const unsigned long long v = (unsigned long long)p; const unsigned lo = __builtin_amdgcn_readfirstlane((unsigned)v), hi = __builtin_amdgcn_readfirstlane((unsigned)(v >> 32));
    return (const char*)(((unsigned long long)hi << 32) | lo); }
__device__ __forceinline__ void ald(unsigned& v, const void* base, unsigned off) {
#ifdef MK_NOASMLD
    v = *(const unsigned*)((const char*)base + off);
#else
    asm volatile("s_nop 4\n\tglobal_load_dword %0, %1, %2" : "+v"(v) : "v"(off), "s"(base) : "memory");
#endif
}
struct Unit { int pm, pn, e; };

struct GridOrder {
    int nM, nN, nwg, G, c;
    __device__ __forceinline__ void init(int nM_, int nN_, int G_, int c_) { nM = __builtin_amdgcn_readfirstlane(nM_); nN = nN_; nwg = nM * nN; G = G_; c = __builtin_amdgcn_readfirstlane(c_); }
    __device__ __forceinline__ bool tile(int i, int& pm, int& pn) const {
        const int L = i * G + c; if (L >= nwg) return false;
        int wgid = L; { const int q = nwg / NXCD, r = nwg % NXCD, xcd = wgid % NXCD, off = wgid / NXCD; wgid = (xcd < r ? xcd * (q + 1) : r * (q + 1) + (xcd - r) * q) + off; }
        const int nig = WGM * nN, gid = wgid / nig, fm = gid * WGM, gsz = (nM - fm) < WGM ? (nM - fm) : WGM;
        pm = fm + ((wgid % nig) % gsz); pn = (wgid % nig) / gsz; return true;
    }
};
struct DenseSched {
    GridOrder o; const void* A; const void* Bt; int lda, ldb;
    __device__ __forceinline__ bool next(int i, Unit& u) const { u.e = 0; return o.tile(i, u.pm, u.pn); }
    __device__ __forceinline__ const char* a_ptr(const Unit& u) const { return (const char*)A + (size_t)u.pm * BM * lda; }
    __device__ __forceinline__ const char* b_ptr(const Unit& u) const { return (const char*)Bt + (size_t)u.pn * BM * ldb; }
    __device__ __forceinline__ unsigned a_off(const Unit&, int) const { return 0u; }
    __device__ __forceinline__ void a_raw(unsigned&, const Unit&, int) const {}
    __device__ __forceinline__ unsigned a_fix(const Unit&, int, int) const { return 0u; }
};
struct MoeSched {
    GridOrder o; const void* A; const void* Bt; int lda, ldb, nBrows; const LAS int* tstart;
    const int* list; const gu32* cnt; bool gather;
    __device__ __forceinline__ bool next(int i, Unit& u) const {
        if (!o.tile(i, u.pm, u.pn)) return false;
        int lo = 0;
#pragma unroll
        for (int s = 16; s >= 1; s >>= 1) { if (tstart[lo + s] <= u.pm) lo += s; }
        u.e = lo; return true;
    }
    __device__ __forceinline__ const char* a_ptr(const Unit& u) const { return gather ? (const char*)A : (const char*)A + (size_t)u.pm * BM * lda; }
    __device__ __forceinline__ const char* b_ptr(const Unit& u) const { return (const char*)Bt + ((size_t)u.e * nBrows + (size_t)u.pn * BM) * ldb; }
    __device__ __forceinline__ void a_raw(unsigned& dst, const Unit& u, int r) const { ald(dst, uni((const char*)list), (unsigned)(u.e * LIST_CAP + (u.pm - tstart[u.e]) * BM + r) * 4u); }
    __device__ __forceinline__ unsigned a_fix(const Unit& u, int r, int raw) const { const int rr = (u.pm - tstart[u.e]) * BM + r; return (unsigned)(rr < tstart[40 + u.e] ? raw : 0) * (unsigned)lda; }
    __device__ __forceinline__ unsigned a_off(const Unit& u, int r) const { unsigned raw = 0u; a_raw(raw, u, r); asm volatile("s_waitcnt vmcnt(0)" : "+v"(raw) :: "memory"); return a_fix(u, r, (int)raw); }
};

template <class Epi, class Sched, bool GATHER, bool FP8 = false>
__device__ __forceinline__ void gemm_phase(LAS unsigned char* lds, const int Kb, const Sched& S, const Epi& E) {
    int tid_ = threadIdx.x; asm volatile("" : "+v"(tid_));
    const int tid = tid_, wid = __builtin_amdgcn_readfirstlane(tid >> 6), lane = tid & 63, wr = wid >> 2, wc = wid & 3, fr = lane & 15, fq = lane >> 4;
    const int nt = Kb / (BK * 2);
    const int lda = S.lda, ldb = S.ldb;
    unsigned voffA[2], voffB[2]; int rowA[2];
#pragma unroll
    for (int i = 0; i < 2; ++i) { int R, C; stage_rc(tid * 16 + i * 8192, R, C); const int Rb = Epi::PERM ? ((R & ~31) + perm32(R & 31)) : R;
        rowA[i] = R; voffA[i] = GATHER ? (unsigned)(C * 2) : (unsigned)(R * lda + C * 2); voffB[i] = (unsigned)(Rb * ldb + C * 2); }
    const size_t kstep = (size_t)(BK * 2);
    const size_t hstepA = GATHER ? 0 : (size_t)HALF * lda, hstepB = (size_t)HALF * ldb;
    const unsigned ldsw = (unsigned)wid * 1024u, lds0 = (unsigned)(uintptr_t)lds;
    const int aoff = lds_byte(wr * 64 + fr, fq * 8), boff = lds_byte(wc * 32 + fr, fq * 8);
#define PG8_SA(b, h) (((b) * 2 + (h)) * HTB)
#define PG8_SB(b, h) ((4 + (b) * 2 + (h)) * HTB)
#define PG8_STAGE(bufoff, gbase, voff) do { _Pragma("unroll") for (int _i = 0; _i < 2; ++_i) { \
        if constexpr (GATHER) asm volatile("s_mov_b32 m0, %2\n\ts_nop 4\n\tglobal_load_lds_dwordx4 %0, %1" :: "v"((voff)[_i]), "s"((const char*)(gbase)), "s"(lds0 + (unsigned)(bufoff) + ldsw + (unsigned)(_i * 8192)) : "memory", "m0"); \
        else __builtin_amdgcn_global_load_lds((const unsigned*)((const char*)(gbase) + (voff)[_i]), (LAS unsigned*)(lds + (bufoff) + ldsw + _i * 8192), 16, 0, 0); } } while (0)
#define PG8_LD16(p) (*(const LAS i32x4*)(p))
#define PG8_LDA(dst, b, h) do { _Pragma("unroll") for (int m = 0; m < 4; ++m) { const LAS unsigned char* p_ = lds + PG8_SA(b, h) + aoff + m * 2048; \
        if constexpr (FP8) dst##8[m] = __builtin_shufflevector(PG8_LD16(p_), PG8_LD16(p_ + 1024), 0, 1, 2, 3, 4, 5, 6, 7); \
        else { dst[m][0] = *(const LAS bf16x8*)p_; dst[m][1] = *(const LAS bf16x8*)(p_ + 1024); } } } while (0)
#define PG8_LDB(dst, b, h) do { _Pragma("unroll") for (int n = 0; n < 2; ++n) { const LAS unsigned char* p_ = lds + PG8_SB(b, h) + boff + n * 2048; \
        if constexpr (FP8) dst##8[n] = __builtin_shufflevector(PG8_LD16(p_), PG8_LD16(p_ + 1024), 0, 1, 2, 3, 4, 5, 6, 7); \
        else { dst[n][0] = *(const LAS bf16x8*)p_; dst[n][1] = *(const LAS bf16x8*)(p_ + 1024); } } } while (0)
#define PG8_MMA(ai, bj, At, Bt) do { __builtin_amdgcn_s_setprio(1); _Pragma("unroll") for (int m = 0; m < 4; ++m) _Pragma("unroll") for (int n = 0; n < 2; ++n) { \
        if constexpr (FP8) asm volatile("v_mfma_f32_16x16x128_f8f6f4 %0, %1, %2, %0" : "+v"(acc[ai][bj][m][n]) : "v"(Bt##8[n]), "v"(At##8[m]));   \
        else { _Pragma("unroll") for (int k = 0; k < 2; ++k) acc[ai][bj][m][n] = __builtin_amdgcn_mfma_f32_16x16x32_bf16(Bt[n][k], At[m][k], acc[ai][bj][m][n], 0, 0, 0); } } \
        __builtin_amdgcn_s_setprio(0); } while (0)
#define PG8_WAIT_V(n) asm volatile("s_waitcnt vmcnt(" #n ")" ::: "memory")
#define PG8_WAIT_L(n) asm volatile("s_waitcnt lgkmcnt(" #n ")" ::: "memory")
#define PG8_BAR __builtin_amdgcn_s_barrier()
#define PG8_SCHED __builtin_amdgcn_sched_barrier(0)
    unsigned utab_off = UTAB_OFF; asm volatile("" : "+s"(utab_off));
    LAS int* utab = (LAS int*)(lds + utab_off);
    if (tid < 64) { Unit t; utab[tid] = S.next(tid, t) ? (t.pm | (t.pn << 12) | (t.e << 20)) : -1; }
    __syncthreads();
    auto unit_at = [&](int i, Unit& u) -> bool { const int v = __builtin_amdgcn_readfirstlane(i < 64 ? utab[i] : -1); if (v < 0) return false; u.pm = v & 0xfff; u.pn = (v >> 12) & 0xff; u.e = v >> 20; return true; };
    Unit cur, nxt; int ui = 0;
    if (!unit_at(0, cur)) return;
    f32x4 acc[2][2][4][2];
#pragma unroll
    for (int a = 0; a < 2; ++a)
#pragma unroll
        for (int b = 0; b < 2; ++b)
#pragma unroll
            for (int m = 0; m < 4; ++m)
#pragma unroll
                for (int n = 0; n < 2; ++n) acc[a][b][m][n] = (f32x4){0.f, 0.f, 0.f, 0.f};
    bf16x8 At[4][2], B0[2][2], B1[2][2];
    i32x8 At8[4], B08[2], B18[2];
    const char* cA = uni(S.a_ptr(cur)); const char* cB = uni(S.b_ptr(cur));
    unsigned c0[2] = {voffA[0], voffA[1]}, c1[2] = {voffA[0], voffA[1]};
    LAS float* sidetab = (LAS float*)(lds + STAGE_BYTES + 8192);
    LAS u32x4* nslot = (LAS u32x4*)(lds + STAGE_BYTES) + tid;
    if constexpr (GATHER) {
#pragma unroll
        for (int i = 0; i < 2; ++i) { c0[i] = 0u; c1[i] = 0u; S.a_raw(c0[i], cur, rowA[i]); S.a_raw(c1[i], cur, HALF + rowA[i]); }
        asm volatile("s_waitcnt vmcnt(0)" : "+v"(c0[0]), "+v"(c0[1]), "+v"(c1[0]), "+v"(c1[1]) :: "memory");
#pragma unroll
        for (int i = 0; i < 2; ++i) { c0[i] = voffA[i] + S.a_fix(cur, rowA[i], (int)c0[i]); c1[i] = voffA[i] + S.a_fix(cur, HALF + rowA[i], (int)c1[i]); }
    }
#define PG8_STAGE_A(bufoff, kptr, h, o0, o1) do { if constexpr (GATHER) { if ((h) == 0) PG8_STAGE(bufoff, kptr, o0); else PG8_STAGE(bufoff, kptr, o1); } \
        else { PG8_STAGE(bufoff, (kptr) + (h) * hstepA, voffA); } } while (0)
    PG8_STAGE(PG8_SB(0, 0), cB, voffB); PG8_STAGE(PG8_SB(0, 1), cB + hstepB, voffB); PG8_STAGE_A(PG8_SA(0, 0), cA, 0, c0, c1); PG8_STAGE_A(PG8_SA(0, 1), cA, 1, c0, c1);
    if (wr == 1) PG8_BAR;
    PG8_WAIT_V(2); PG8_BAR;
    PG8_STAGE(PG8_SB(1, 0), cB + kstep, voffB); PG8_STAGE_A(PG8_SA(1, 0), cA + kstep, 0, c0, c1); PG8_STAGE(PG8_SB(1, 1), cB + hstepB + kstep, voffB);
    PG8_WAIT_V(6); PG8_BAR;
    bool has_next = unit_at(1, nxt);
    if constexpr (Epi::SIDE) { unsigned s0[2] = {0u, 0u}, s1[2] = {0u, 0u}; E.side_load(s0, cur, tid & 255); E.side_load(s1, has_next ? nxt : cur, tid & 255);
        asm volatile("s_waitcnt vmcnt(0)" : "+v"(s0[0]), "+v"(s0[1]), "+v"(s1[0]), "+v"(s1[1]) :: "memory");
        if (tid < 256) { sidetab[tid] = __builtin_bit_cast(float, s0[0]); sidetab[512 + tid] = __builtin_bit_cast(float, s1[0]); if constexpr (Epi::SIDE2) { sidetab[256 + tid] = __builtin_bit_cast(float, s0[1]); sidetab[768 + tid] = __builtin_bit_cast(float, s1[1]); } } }
    if constexpr (GATHER) { u32x4 nv = {c0[0], c0[1], c1[0], c1[1]};
        if (has_next) { unsigned r0 = 0u, r1 = 0u, r2 = 0u, r3 = 0u; S.a_raw(r0, nxt, rowA[0]); S.a_raw(r1, nxt, rowA[1]); S.a_raw(r2, nxt, HALF + rowA[0]); S.a_raw(r3, nxt, HALF + rowA[1]);
            asm volatile("s_waitcnt vmcnt(0)" : "+v"(r0), "+v"(r1), "+v"(r2), "+v"(r3) :: "memory");
            nv = (u32x4){voffA[0] + S.a_fix(nxt, rowA[0], (int)r0), voffA[1] + S.a_fix(nxt, rowA[1], (int)r1), voffA[0] + S.a_fix(nxt, HALF + rowA[0], (int)r2), voffA[1] + S.a_fix(nxt, HALF + rowA[1], (int)r3)}; }
        *nslot = nv; }
    for (;;) {
        const char* nA = has_next ? uni(S.a_ptr(nxt)) : cA; const char* nB = has_next ? uni(S.b_ptr(nxt)) : cB;
        Unit nn; const bool has_nn = has_next && unit_at(ui + 2, nn);
        if (!has_nn) nn = cur;
        unsigned raw[4] = {0u, 0u, 0u, 0u}, sraw[2] = {0u, 0u};
        if constexpr (Epi::SIDE) E.side_load(sraw, nn, tid & 255);
        if constexpr (GATHER) { int t2 = threadIdx.x; asm volatile("" : "+v"(t2));
#pragma unroll
            for (int i = 0; i < 2; ++i) { int R, C; stage_rc(t2 * 16 + i * 8192, R, C); S.a_raw(raw[i], nn, R); S.a_raw(raw[2 + i], nn, HALF + R); } }
        constexpr int NLOOK = (Epi::SIDE ? (Epi::SIDE2 ? 2 : 1) : 0) + (GATHER ? 4 : 0);
#define PG8_KBODY(a1_, a2_, b2_, X0, X1) do { const char* a3_ = (a2_) + kstep; const char* b3_ = (b2_) + kstep; \
              \
            PG8_LDB(B0, 0, 0); PG8_LDB(B1, 0, 1); PG8_SCHED; PG8_LDA(At, 0, 0); PG8_STAGE_A(PG8_SA(1, 1), a1_, 1, c0, c1); \
            PG8_WAIT_V(8); PG8_WAIT_L(0); PG8_BAR; PG8_MMA(0, 0, At, B0); PG8_MMA(0, 1, At, B1); PG8_BAR; PG8_SCHED; \
              \
            PG8_LDA(At, 0, 1); PG8_STAGE(PG8_SB(0, 0), b2_, voffB); PG8_STAGE(PG8_SB(0, 1), (b2_) + hstepB, voffB); PG8_STAGE_A(PG8_SA(0, 0), a2_, 0, X0, X1); \
            PG8_WAIT_V(8); PG8_WAIT_L(0); PG8_BAR; PG8_MMA(1, 0, At, B0); PG8_MMA(1, 1, At, B1); PG8_BAR; PG8_SCHED; \
              \
            PG8_LDB(B0, 1, 0); PG8_LDB(B1, 1, 1); PG8_SCHED; PG8_LDA(At, 1, 0); PG8_STAGE_A(PG8_SA(0, 1), a2_, 1, X0, X1); \
            PG8_WAIT_V(8); PG8_WAIT_L(0); PG8_BAR; PG8_MMA(0, 0, At, B0); PG8_MMA(0, 1, At, B1); PG8_BAR; PG8_SCHED; \
              \
            PG8_LDA(At, 1, 1); PG8_STAGE(PG8_SB(1, 0), b3_, voffB); PG8_STAGE(PG8_SB(1, 1), b3_ + hstepB, voffB); PG8_STAGE_A(PG8_SA(1, 0), a3_, 0, X0, X1); \
            PG8_WAIT_V(8); PG8_WAIT_L(0); PG8_BAR; PG8_MMA(1, 0, At, B0); PG8_MMA(1, 1, At, B1); PG8_BAR; PG8_SCHED; } while (0)
#define PG8_WAIT_VI(n) asm volatile("s_waitcnt vmcnt(%0)" :: "i"(n) : "memory")
#define PG8_KBODY_FIRST(a2_, b2_, NS) do { const char* a3_ = (a2_) + kstep; const char* b3_ = (b2_) + kstep; \
            PG8_LDB(B0, 0, 0); PG8_LDB(B1, 0, 1); PG8_SCHED; PG8_LDA(At, 0, 0); \
            PG8_WAIT_VI(8 + NS); PG8_WAIT_L(0); PG8_BAR; PG8_MMA(0, 0, At, B0); PG8_MMA(0, 1, At, B1); PG8_BAR; PG8_SCHED; \
            PG8_LDA(At, 0, 1); PG8_STAGE(PG8_SB(0, 0), b2_, voffB); PG8_STAGE(PG8_SB(0, 1), (b2_) + hstepB, voffB); PG8_STAGE_A(PG8_SA(0, 0), a2_, 0, c0, c1); \
            PG8_WAIT_VI(8 + NS); PG8_WAIT_L(0); PG8_BAR; PG8_MMA(1, 0, At, B0); PG8_MMA(1, 1, At, B1); PG8_BAR; PG8_SCHED; \
            PG8_LDB(B0, 1, 0); PG8_LDB(B1, 1, 1); PG8_SCHED; PG8_LDA(At, 1, 0); PG8_STAGE_A(PG8_SA(0, 1), a2_, 1, c0, c1); \
            PG8_WAIT_VI(8 + NS); PG8_WAIT_L(0); PG8_BAR; PG8_MMA(0, 0, At, B0); PG8_MMA(0, 1, At, B1); PG8_BAR; PG8_SCHED; \
            PG8_LDA(At, 1, 1); PG8_STAGE(PG8_SB(1, 0), b3_, voffB); PG8_STAGE(PG8_SB(1, 1), b3_ + hstepB, voffB); PG8_STAGE_A(PG8_SA(1, 0), a3_, 0, c0, c1); \
            PG8_WAIT_V(8); PG8_WAIT_L(0); PG8_BAR; PG8_MMA(1, 0, At, B0); PG8_MMA(1, 1, At, B1); PG8_BAR; PG8_SCHED; } while (0)
        constexpr bool RELAX = (MK_DUP != 101) && Epi::NSTORE > 0;
        if constexpr (GATHER) {
            int t0 = 0;
            if constexpr (RELAX) { if (ui > 0) { PG8_KBODY_FIRST(cA + 2 * kstep, cB + 2 * kstep, Epi::NSTORE + NLOOK); t0 = 2; } }
            for (int t = t0; t < nt - 2; t += 2) { const char* a1 = cA + (size_t)(t + 1) * kstep; const char* a2 = cA + (size_t)(t + 2) * kstep; const char* b2 = cB + (size_t)(t + 2) * kstep; PG8_KBODY(a1, a2, b2, c0, c1); }
            { const u32x4 nv = *nslot; const unsigned n0[2] = {nv[0], nv[1]}, n1[2] = {nv[2], nv[3]}; const char* a1 = cA + (size_t)(nt - 1) * kstep; PG8_KBODY(a1, nA, nB, n0, n1);
              if constexpr (RELAX) { if (has_next) PG8_STAGE_A(PG8_SA(1, 1), nA + kstep, 1, n0, n1); } }
        } else {
            constexpr int REP = (MK_DUP == 101 && FP8) ? 2 : 1;
            int tt0 = 0;
            if constexpr (RELAX) { if (ui > 0) { PG8_KBODY_FIRST(cA + 2 * kstep, cB + 2 * kstep, Epi::NSTORE + NLOOK); tt0 = 2; } }
            for (int tt = tt0; tt < REP * nt; tt += 2) {
                const int t = REP == 1 ? tt : (tt >= nt ? tt - nt : tt);
                if constexpr (Epi::MIDK) { if (tt == nt / 2) E.midk(acc, wr, fr, sidetab + (ui % 3) * 512); }
                const bool last = (tt == REP * nt - 2), wrap = (t == nt - 2);
                const char* a1 = cA + (size_t)(t + 1) * kstep;
                const char* a2 = last ? nA : (wrap ? cA : cA + (size_t)(t + 2) * kstep); const char* b2 = last ? nB : (wrap ? cB : cB + (size_t)(t + 2) * kstep);
                PG8_KBODY(a1, a2, b2, c0, c1);
            }
            if constexpr (RELAX) { if (has_next) PG8_STAGE_A(PG8_SA(1, 1), nA + kstep, 1, c0, c1); }
        }
        if (wr == 0) PG8_BAR;
        if constexpr (FP8) asm volatile("s_nop 15\n\ts_nop 15" ::: "memory");
        { int t2 = threadIdx.x; asm volatile("" : "+v"(t2)); const int l2 = t2 & 63, w2 = t2 >> 6;
          if constexpr (Epi::SIDE) E(acc, cur, w2 >> 2, w2 & 3, l2 & 15, l2 >> 4, sidetab + (ui % 3) * 512); else E(acc, cur, w2 >> 2, w2 & 3, l2 & 15, l2 >> 4); }
        if (!has_next) break;
#pragma unroll
        for (int a = 0; a < 2; ++a)
#pragma unroll
            for (int b = 0; b < 2; ++b)
#pragma unroll
                for (int m = 0; m < 4; ++m)
#pragma unroll
                    for (int n = 0; n < 2; ++n) acc[a][b][m][n] = (f32x4){0.f, 0.f, 0.f, 0.f};
        cur = nxt; cA = nA; cB = nB; ++ui;
        asm volatile("" : "+v"(raw[0]), "+v"(raw[1]), "+v"(raw[2]), "+v"(raw[3]), "+v"(sraw[0]), "+v"(sraw[1]));
        if constexpr (GATHER) { const u32x4 nv = *nslot; c0[0] = nv[0]; c0[1] = nv[1]; c1[0] = nv[2]; c1[1] = nv[3];
            if (has_nn) { int t2 = threadIdx.x; asm volatile("" : "+v"(t2)); u32x4 nw;
#pragma unroll
                for (int i = 0; i < 2; ++i) { int R, C; stage_rc(t2 * 16 + i * 8192, R, C); const unsigned vo = (unsigned)(C * 2); nw[i] = vo + S.a_fix(nn, R, (int)raw[i]); nw[2 + i] = vo + S.a_fix(nn, HALF + R, (int)raw[2 + i]); }
                *nslot = nw; } }
        if constexpr (Epi::SIDE) { if (has_nn) { LAS float* t3 = sidetab + ((ui + 1) % 3) * 512; if (tid < 256) { t3[tid] = __builtin_bit_cast(float, sraw[0]); if constexpr (Epi::SIDE2) t3[256 + tid] = __builtin_bit_cast(float, sraw[1]); } } }
        nxt = nn; has_next = has_nn;
        if (wr == 1) PG8_BAR;
    }
    PG8_WAIT_V(0);
    PG8_BAR;
#undef PG8_SA
#undef PG8_SB
#undef PG8_STAGE
#undef PG8_STAGE_A
#undef PG8_KBODY
#undef PG8_KBODY_FIRST
#undef PG8_WAIT_VI
#undef PG8_LDA
#undef PG8_LDB
#undef PG8_MMA
#undef PG8_LD16
#undef PG8_WAIT_V
#undef PG8_WAIT_L
#undef PG8_BAR
#undef PG8_SCHED
}
}

namespace att {
constexpr int NW = 8, QBLK = 32, KVBLK = 64, QB = NW * QBLK;
constexpr int SHM_V = KVBLK * 128 * 2, KP = 272, SHM_K = KVBLK * KP, KRP = 144, SHM_KR = KVBLK * KRP, QLP = 208, SHM_QR = QBLK * QLP;
constexpr int OFF_V = 0, OFF_K = 2 * SHM_V, OFF_KR = OFF_K + 2 * SHM_K, OFF_WS = OFF_KR + 2 * SHM_KR, OFF_NC = OFF_WS + NW * 64 * 4, OFF_QR = OFF_NC + 2 * 256, LDS_BYTES = OFF_QR + NW * SHM_QR;
constexpr int LDO = 2048;
constexpr int K8P = 208, SHM_K8 = KVBLK * K8P;
#define KSWZ(row, colB) ((row) * KP + (colB))
#define KRSWZ(row, colB) ((row) * KRP + (colB))
#define SBAR() __builtin_amdgcn_sched_barrier(0)
__device__ __forceinline__ int v_st(int k, int c) { const int kk = (k & ~0xC) | ((k & 4) << 1) | ((k & 8) >> 1); return ((kk >> 3) * 4 + (c >> 5)) * 512 + ((kk & 7) * 32 + (c & 31)) * 2; }
__device__ __forceinline__ int v_rd_base(int lane) { return ((lane & 3) << 3) | (((lane >> 2) & 3) << 6) | (((lane >> 4) & 1) << 5) | (((lane >> 5) & 1) << 8); }
constexpr int v_rd_off(int d0, int ks, int half) { return d0 * 512 + ks * 4096 + half * 2048; }
__device__ __forceinline__ int crow(int r, int hi) { return (r & 3) + 8 * (r >> 2) + 4 * hi; }
__device__ __forceinline__ bf16x8 load8(const bf16_t* p) { return *reinterpret_cast<const bf16x8*>(p); }
__device__ __forceinline__ void mask_tile(f32x16& p0, f32x16& p1, int dq) {
    const float NEG = -__builtin_inff();
#pragma unroll
    for (int r = 0; r < 16; ++r) {
        const int c = (r & 3) + 8 * (r >> 2);
        if (dq - c < 0) p0[r] = NEG;
        if (dq - c - 32 < 0) p1[r] = NEG;
    }
}
template <int DK>
__device__ __forceinline__ void partialSM(f32x16& p0, f32x16& p1, float& m_reg, float& mn, float& alpha) {
    constexpr float SCALE = DK == 128 ? 0.08838834764831845f : 0.07216878364870323f, THR = 8.f;
    float pmax = p0[0];
#pragma unroll
    for (int r = 1; r < 16; ++r) pmax = fmaxf(pmax, p0[r]);
#pragma unroll
    for (int r = 0; r < 16; ++r) pmax = fmaxf(pmax, p1[r]);
    { auto rr = __builtin_amdgcn_permlane32_swap(__float_as_uint(pmax), __float_as_uint(pmax), false, false);
      pmax = fmaxf(__uint_as_float(rr[0]), __uint_as_float(rr[1])); }
    constexpr float C2 = 1.4426950408889634f * SCALE;
    if (__builtin_expect(__all((pmax - m_reg) * SCALE <= THR), 1)) { mn = m_reg; alpha = 1.f; }
    else { mn = fmaxf(m_reg, pmax); alpha = __builtin_amdgcn_exp2f((m_reg - mn) * C2); m_reg = mn; }
    const float mnL = -mn * C2;
#pragma unroll
    for (int r = 0; r < 16; ++r) p0[r] = fmaf(p0[r], C2, mnL);
#pragma unroll
    for (int r = 0; r < 16; ++r) p1[r] = fmaf(p1[r], C2, mnL);
#pragma unroll
    for (int r = 0; r < 16; ++r) p0[r] = __builtin_amdgcn_exp2f(p0[r]);
}
__device__ __forceinline__ void finishSM(f32x16& p0, f32x16& p1, float alpha, float& l_reg, bf16x8& pa0, bf16x8& pa1, bf16x8& pa2, bf16x8& pa3) {
#pragma unroll
    for (int r = 0; r < 16; ++r) p1[r] = __builtin_amdgcn_exp2f(p1[r]);
    float ps = 0;
#pragma unroll
    for (int r = 0; r < 16; ++r) ps += p0[r];
#pragma unroll
    for (int r = 0; r < 16; ++r) ps += p1[r];
    { auto rr = __builtin_amdgcn_permlane32_swap(__float_as_uint(ps), __float_as_uint(ps), false, false);
      ps = __uint_as_float(rr[0]) + __uint_as_float(rr[1]); }
    l_reg = l_reg * alpha + ps;
#define PK4(P, B_, OUT) do { unsigned a0 = cvt_pk_bf16(P[B_+0], P[B_+1]), a1 = cvt_pk_bf16(P[B_+2], P[B_+3]);                  \
        unsigned b0 = cvt_pk_bf16(P[B_+4], P[B_+5]), b1 = cvt_pk_bf16(P[B_+6], P[B_+7]);                                       \
        auto r0 = __builtin_amdgcn_permlane32_swap(a0, b0, false, false); auto r1 = __builtin_amdgcn_permlane32_swap(a1, b1, false, false); \
        u32x4 w = {r0[0], r1[0], r0[1], r1[1]}; OUT = *reinterpret_cast<bf16x8*>(&w); } while (0)
    PK4(p0, 0, pa0); PK4(p0, 8, pa1); PK4(p1, 0, pa2); PK4(p1, 8, pa3);
#undef PK4
}
template <int KB>
__device__ __forceinline__ void qkt8(f32x16& p0, f32x16& p1, const char* lds, int r32, int hi, const i32x8* q8) {
    p0 = f32x16{}; p1 = f32x16{};
    const char* kb = lds + OFF_K + KB * SHM_K8 + r32 * K8P + hi * 32;
#pragma unroll
    for (int s = 0; s < 3; ++s) {
        const i32x4 a0 = *reinterpret_cast<const i32x4*>(kb + 64 * s), a1 = *reinterpret_cast<const i32x4*>(kb + 64 * s + 16);
        const i32x4 b0 = *reinterpret_cast<const i32x4*>(kb + 64 * s + 32 * K8P), b1 = *reinterpret_cast<const i32x4*>(kb + 64 * s + 32 * K8P + 16);
        p0 = __builtin_amdgcn_mfma_scale_f32_32x32x64_f8f6f4(__builtin_shufflevector(a0, a1, 0, 1, 2, 3, 4, 5, 6, 7), q8[s], p0, 0, 0, 0, 0, 0, 0);
        p1 = __builtin_amdgcn_mfma_scale_f32_32x32x64_f8f6f4(__builtin_shufflevector(b0, b1, 0, 1, 2, 3, 4, 5, 6, 7), q8[s], p1, 0, 0, 0, 0, 0, 0); }
}
template <int KB, int DK, bool BIAS>
__device__ __forceinline__ void qkt(f32x16& p0, f32x16& p1, const char* lds, int r32, int hi, const bf16x8* qr) {
    if constexpr (BIAS) {
        const float* nc = (const float*)(lds + OFF_NC + KB * 256);
#pragma unroll
        for (int g = 0; g < 4; ++g) { const f32x4 a = *(const f32x4*)(nc + 8 * g + 4 * hi), b = *(const f32x4*)(nc + 32 + 8 * g + 4 * hi);
            p0[4 * g] = a[0]; p0[4 * g + 1] = a[1]; p0[4 * g + 2] = a[2]; p0[4 * g + 3] = a[3];
            p1[4 * g] = b[0]; p1[4 * g + 1] = b[1]; p1[4 * g + 2] = b[2]; p1[4 * g + 3] = b[3]; }
    } else { p0 = f32x16{}; p1 = f32x16{}; }
    const char* kb = lds + OFF_K + KB * SHM_K + r32 * KP + hi * 16;
#pragma unroll
    for (int d0 = 0; d0 < 8; ++d0) {
        bf16x8 b0 = *reinterpret_cast<const bf16x8*>(kb + d0 * 32);
        bf16x8 b1 = *reinterpret_cast<const bf16x8*>(kb + d0 * 32 + 32 * KP);
        p0 = __builtin_amdgcn_mfma_f32_32x32x16_bf16(b0, qr[d0], p0, 0, 0, 0);
        p1 = __builtin_amdgcn_mfma_f32_32x32x16_bf16(b1, qr[d0], p1, 0, 0, 0); }
}
template <int VB>
__device__ __forceinline__ void pv_tile(f32x16* o, int vb0, bf16x8 pa0, bf16x8 pa1, bf16x8 pa2, bf16x8 pa3) {
#define TRRD(dst, off) asm volatile("ds_read_b64_tr_b16 %0, %1 offset:%2" : "=&v"(dst) : "v"(vb0), "i"(off) : "memory")
#define PV_RD(d0, p, X0, X1, X2, X3) do { constexpr int b_ = VB * SHM_V + v_rd_off(d0, 0, 0) + (p) * 8192; TRRD(X0, b_); TRRD(X1, b_ + 2048); TRRD(X2, b_ + 4096); TRRD(X3, b_ + 6144); } while (0)
#define PV_MM(d0, PA, PB, X0, X1, X2, X3) do { \
        o[d0] = __builtin_amdgcn_mfma_f32_32x32x16_bf16(PA, (bf16x8){X0[0], X0[1], X0[2], X0[3], X1[0], X1[1], X1[2], X1[3]}, o[d0], 0, 0, 0); \
        o[d0] = __builtin_amdgcn_mfma_f32_32x32x16_bf16(PB, (bf16x8){X2[0], X2[1], X2[2], X2[3], X3[0], X3[1], X3[2], X3[3]}, o[d0], 0, 0, 0); } while (0)
#define PV_W4() do { asm volatile("s_waitcnt lgkmcnt(4)" ::: "memory"); SBAR(); } while (0)
#define PV_W0() do { asm volatile("s_waitcnt lgkmcnt(0)" ::: "memory"); SBAR(); } while (0)
#define PV_RH(q, X0, X1) do { constexpr int b_ = VB * SHM_V + v_rd_off((q) & 3, 0, 0) + ((q) >> 2) * 4096; TRRD(X0, b_); TRRD(X1, b_ + 2048); } while (0)
#define PV_M1(q, PA, X0, X1) o[(q) & 3] = __builtin_amdgcn_mfma_f32_32x32x16_bf16(PA, (bf16x8){X0[0], X0[1], X0[2], X0[3], X1[0], X1[1], X1[2], X1[3]}, o[(q) & 3], 0, 0, 0)
#define PV_WN(n) do { asm volatile("s_waitcnt lgkmcnt(" #n ")" ::: "memory"); SBAR(); } while (0)
    s16x4 h0l, h0h, h1l, h1h, h2l, h2h, h3l, h3h, h4l, h4h;
    PV_RH(0, h0l, h0h); PV_RH(1, h1l, h1h); PV_RH(2, h2l, h2h); PV_RH(3, h3l, h3h); PV_RH(4, h4l, h4h); SBAR();
    PV_WN(8); PV_M1(0, pa0, h0l, h0h); SBAR(); PV_RH(5, h0l, h0h); SBAR();
    PV_WN(8); PV_M1(1, pa0, h1l, h1h); SBAR(); PV_RH(6, h1l, h1h); SBAR();
    PV_WN(8); PV_M1(2, pa0, h2l, h2h); SBAR(); PV_RH(7, h2l, h2h); SBAR();
    PV_WN(8); PV_M1(3, pa0, h3l, h3h); SBAR(); PV_RH(8, h3l, h3h); SBAR();
    PV_WN(8); PV_M1(4, pa1, h4l, h4h); SBAR(); PV_RH(9, h4l, h4h); SBAR();
    PV_WN(8); PV_M1(5, pa1, h0l, h0h); SBAR(); PV_RH(10, h0l, h0h); SBAR();
    PV_WN(8); PV_M1(6, pa1, h1l, h1h); SBAR(); PV_RH(11, h1l, h1h); SBAR();
    PV_WN(8); PV_M1(7, pa1, h2l, h2h); SBAR(); PV_RH(12, h2l, h2h); SBAR();
    PV_WN(8); PV_M1(8, pa2, h3l, h3h); SBAR(); PV_RH(13, h3l, h3h); SBAR();
    PV_WN(8); PV_M1(9, pa2, h4l, h4h); SBAR(); PV_RH(14, h4l, h4h); SBAR();
    PV_WN(8); PV_M1(10, pa2, h0l, h0h); SBAR(); PV_RH(15, h0l, h0h); SBAR();
    PV_WN(8); PV_M1(11, pa2, h1l, h1h); SBAR();
    PV_WN(6); PV_M1(12, pa3, h2l, h2h); SBAR();
    PV_WN(4); PV_M1(13, pa3, h3l, h3h); SBAR();
    PV_WN(2); PV_M1(14, pa3, h4l, h4h); SBAR();
    PV_WN(0); PV_M1(15, pa3, h0l, h0h); SBAR();
#undef PV_RH
#undef PV_M1
#undef PV_WN
#undef PV_RD
#undef PV_MM
#undef PV_W4
#undef PV_W0
#undef TRRD
}

struct Group { const bf16_t* Q; const bf16_t* K; const bf16_t* V; const bf16_t* KR; const float* NC; bf16_t* O; float* SS; int qhs, khs, slot0; };
struct BlockRef { int bh, P0; float W; };
#define R_TOK(R) ((size_t)((R).bh >> 3) * SEQ)
#define R_Q(R) (G.Q + (R_TOK(R) + (R).P0) * LDQ + ((R).bh & 7) * G.qhs)
#define R_K(R) (G.K + R_TOK(R) * LDK + ((R).bh & 7) * G.khs)
#define R_V(R) (G.V + R_TOK(R) * LDV + ((R).bh & 7) * G.khs)
#define R_KR(R) (G.KR + R_TOK(R) * 64)
#define R_NC(R) (G.NC + (size_t)(R).bh * SEQ)
#define R_O(R) (G.O + (R_TOK(R) + (R).P0) * LDO + ((R).bh & 7) * 128)
#define R_Q8(R) ((const unsigned char*)G.Q + (R_TOK(R) + (R).P0) * 1536 + ((R).bh & 7) * 192)
#define R_K8(R) ((const unsigned char*)G.K + R_TOK(R) * 1024 + ((R).bh & 7) * 128)
#define R_KR8(R) ((const unsigned char*)G.KR + R_TOK(R) * 64)
#define LD16(p) (*reinterpret_cast<const bf16x8*>(p))
template <int DK> struct Seam { int jlo; bf16x8 qr[8]; i32x8 q8[3]; bf16x8 st_v0, st_v1, st_k0, st_k1, st_kr; float st_c; };

#define AT_QLOAD(R, rr, hh) do { if constexpr (DK == 192) { const unsigned char* qp_ = R_Q8(R) + (size_t)(wid * QBLK + (rr)) * 1536 + 32 * (hh); \
        _Pragma("unroll") for (int s_ = 0; s_ < 3; ++s_) S.q8[s_] = __builtin_shufflevector(__builtin_bit_cast(i32x4, LD16(qp_ + 64 * s_)), __builtin_bit_cast(i32x4, LD16(qp_ + 64 * s_ + 16)), 0, 1, 2, 3, 4, 5, 6, 7); } \
    else { _Pragma("unroll") for (int d0 = 0; d0 < 8; ++d0) S.qr[d0] = load8(R_Q(R) + (size_t)(wid * QBLK + (rr)) * LDQ + d0 * 16 + (hh) * 8); } } while (0)
#define VMW() asm volatile("s_waitcnt vmcnt(0)" ::: "memory")
#define VMWN(n) asm volatile("s_waitcnt vmcnt(%0)" :: "i"(n) : "memory")
#define AT_SLOAD(R, k0) do { S.st_v0 = load8(R_V(R) + (size_t)((k0) + sr) * LDV + sc); S.st_v1 = load8(R_V(R) + (size_t)((k0) + 32 + sr) * LDV + sc);              \
                             if constexpr (DK == 192) { S.st_k0 = LD16(R_K8(R) + (size_t)((k0) + (tid >> 3)) * 1024 + (tid & 7) * 16);                              \
                                                        if (tid < 256) S.st_kr = LD16(R_KR8(R) + (size_t)((k0) + (tid >> 2)) * 64 + (tid & 3) * 16); }            \
                             else { S.st_k0 = load8(R_K(R) + (size_t)((k0) + sr) * LDK + sc); S.st_k1 = load8(R_K(R) + (size_t)((k0) + 32 + sr) * LDK + sc); }      \
                             if constexpr (BIAS) { if (tid < 64) S.st_c = R_NC(R)[(k0) + tid]; } } while (0)
#define AT_SWRITE_K(bf) do { if constexpr (DK == 192) { *(bf16x8*)(K_lds + (bf) * SHM_K8 + (tid >> 3) * K8P + (tid & 7) * 16) = S.st_k0;                            \
                                                        if (tid < 256) *(bf16x8*)(K_lds + (bf) * SHM_K8 + (tid >> 2) * K8P + 128 + (tid & 3) * 16) = S.st_kr; }    \
                             else { *(bf16x8*)(K_lds + (bf) * SHM_K + kws) = S.st_k0; *(bf16x8*)(K_lds + (bf) * SHM_K + kws + 32 * KP) = S.st_k1; }                  \
                             if constexpr (BIAS) { if (tid < 64) ((float*)(lds + OFF_NC + (bf) * 256))[tid] = S.st_c; } } while (0)
#define AT_SWRITE_V(bf) do { *(bf16x8*)(V_lds + (bf) * SHM_V + vst0) = S.st_v0; *(bf16x8*)(V_lds + (bf) * SHM_V + vst1) = S.st_v1; } while (0)
#define AT_SWRITE_VO(off) do { *(bf16x8*)(V_lds + (off) + vst0) = S.st_v0; *(bf16x8*)(V_lds + (off) + vst1) = S.st_v1; } while (0)

template <bool BIAS>
__device__ __forceinline__ int first_tile(const Group& G, const BlockRef& R, int lane) {
    if constexpr (!BIAS) return 0;
    else { int l2 = lane; asm volatile("" : "+v"(l2));
        const float* nc = R_NC(R); const float ref = nc[R.P0], e0 = nc[128 * l2 + 63], e1 = nc[128 * l2 + 127];
        const int n = __popcll(__ballot(ref - e0 >= R.W)) + __popcll(__ballot(ref - e1 >= R.W));
        return __builtin_amdgcn_readfirstlane(n); }
}
template <int DK, bool BIAS, int LDQ, int LDK, int LDV>
__device__ __forceinline__ void prime(const Group& G, const BlockRef& cur, char* lds, Seam<DK>& S) {
    const int tid = threadIdx.x, wid = __builtin_amdgcn_readfirstlane(tid >> 6), lane = tid & 63, r32 = lane & 31, hi = lane >> 5;
    const int sr = tid >> 4, sc = (tid & 15) * 8, kws = KSWZ(sr, sc * 2), krws = KRSWZ(tid >> 3, (tid & 7) * 16); char* K_lds = lds + OFF_K;
    AT_QLOAD(cur, r32, hi);
    S.jlo = first_tile<BIAS>(G, cur, lane);
    AT_SLOAD(cur, S.jlo * KVBLK); VMW(); AT_SWRITE_K(0);
    __syncthreads();
}
template <int DK, bool BIAS, int LDQ, int LDK, int LDV>
__device__ __forceinline__ void block(const Group& G, const BlockRef& cur, const BlockRef& nxt, char* lds, Seam<DK>& S) {
    const int tid = threadIdx.x, wid = __builtin_amdgcn_readfirstlane(tid >> 6), lane = tid & 63, r32 = lane & 31, hi = lane >> 5;
    const int j_lo = S.jlo, NT = (cur.P0 + QB) / KVBLK - j_lo;
    const int jlo_n = first_tile<BIAS>(G, nxt, lane);
    const int qlo = cur.P0 + wid * QBLK, qm = qlo + r32 - 4 * hi;
    char* V_lds = lds + OFF_V; char* K_lds = lds + OFF_K;
    float* ws = (float*)(lds + OFF_WS) + wid * 64; float* li_l = ws, * al_l = ws + 32;
    float m_reg = -1e30f, l_reg = 0; f32x16 o[4] = {};
    const int sr = tid >> 4, sc = (tid & 15) * 8, vst0 = v_st(sr, sc), vst1 = v_st(32 + sr, sc), kws = KSWZ(sr, sc * 2), krws = KRSWZ(tid >> 3, (tid & 7) * 16);
    int vb0 = (int)(uintptr_t)V_lds + v_rd_base(lane);
#define RESC(a) do { if (__any((a) < 1.f)) { if (hi == 0) al_l[r32] = (a); asm volatile("s_waitcnt lgkmcnt(0)" ::: "memory");              \
                     for (int d_ = 0; d_ < 4; ++d_) for (int r = 0; r < 16; ++r) o[d_][r] *= al_l[crow(r, hi)]; } } while (0)
#define QKT(KB_, X0, X1) do { if constexpr (DK == 192) qkt8<KB_>(X0, X1, lds, r32, hi, S.q8); else qkt<KB_, DK, BIAS>(X0, X1, lds, r32, hi, S.qr); } while (0)
#define KBASE(t) ((j_lo + (t)) * KVBLK)
#define MASKT(P0_, P1_, t) do { const int kb_ = KBASE(t); if (kb_ + KVBLK - 1 > qlo) mask_tile(P0_, P1_, qm - kb_); } while (0)
    constexpr int NQL = DK == 192 ? 6 : 8;
#define SEAM_K0() do { VMWN(NQL); AT_SWRITE_K(0); SBAR(); } while (0)
    f32x16 pA0, pA1, pB0, pB1; float mnA, mnB, alA, alB; bf16x8 pa0, pa1, pa2, pa3;
    AT_SWRITE_V(0); SBAR();
    if (NT > 1) AT_SLOAD(cur, KBASE(1));
    SBAR(); QKT(0, pA0, pA1);
    MASKT(pA0, pA1, 0); partialSM<DK>(pA0, pA1, m_reg, mnA, alA);
    if (NT > 1) { VMW(); AT_SWRITE_V(1); AT_SWRITE_K(1); }
    __syncthreads();
    int va = 0, vbn = SHM_V, vc = OFF_KR - OFF_V;
#define HALF_STEP(PX0, PX1, mnX, alX, PY0, PY1, alY, t, KB, VB, SB) do {                                                      \
        SBAR(); QKT(KB, PX0, PX1);                                                              \
        finishSM(PY0, PY1, alY, l_reg, pa0, pa1, pa2, pa3); SBAR();                                                           \
        if ((t) + 1 < NT) { AT_SLOAD(cur, KBASE((t) + 1)); SBAR(); }                                                          \
        pv_tile<0>(o, vb0, pa0, pa1, pa2, pa3); MASKT(PX0, PX1, (t)); partialSM<DK>(PX0, PX1, m_reg, mnX, alX);                \
        if ((t) + 1 < NT) { VMW(); AT_SWRITE_VO(vc); AT_SWRITE_K(SB); }                                                       \
        RESC(alX); { const int t_ = va; vb0 += vbn - va; va = vbn; vbn = vc; vc = t_; } __syncthreads(); } while (0)
    for (int t = 1; t + 1 < NT; t += 2) {
        HALF_STEP(pB0, pB1, mnB, alB, pA0, pA1, alA, t, 1, 0, 0);
        HALF_STEP(pA0, pA1, mnA, alA, pB0, pB1, alB, t + 1, 0, 1, 1);
    }
    const bool even = (NT & 1) == 0;
    int l3 = threadIdx.x & 63; asm volatile("" : "+v"(l3)); const int r32t = l3 & 31, hit = l3 >> 5;
    if (even) { SBAR(); QKT(1, pB0, pB1); SBAR(); }
    AT_SLOAD(nxt, jlo_n * KVBLK); SBAR();
    AT_QLOAD(nxt, r32t, hit);
    SBAR();
    finishSM(pA0, pA1, alA, l_reg, pa0, pa1, pa2, pa3); SBAR();
    pv_tile<0>(o, vb0, pa0, pa1, pa2, pa3);
    if (even) { MASKT(pB0, pB1, NT - 1); partialSM<DK>(pB0, pB1, m_reg, mnB, alB); __syncthreads(); RESC(alB);
        finishSM(pB0, pB1, alB, l_reg, pa0, pa1, pa2, pa3); SBAR(); vb0 += vbn - va; pv_tile<0>(o, vb0, pa0, pa1, pa2, pa3); }
    SBAR(); SEAM_K0();
    if (hi == 0) li_l[r32] = l_reg; asm volatile("s_waitcnt lgkmcnt(0)" ::: "memory");
    float rli[16];
#pragma unroll
    for (int r = 0; r < 16; ++r) rli[r] = __builtin_amdgcn_rcpf(li_l[crow(r, hi)]);
    bf16_t* Ow = R_O(cur) + (size_t)(wid * QBLK) * LDO;
    { float* ssp = G.SS + (R_TOK(cur) + cur.P0 + wid * QBLK) * 16 + G.slot0 + (cur.bh & 7);
#pragma unroll
      for (int r = 0; r < 16; ++r) { float q = 0.f;
#pragma unroll
          for (int d0 = 0; d0 < 4; ++d0) { const float v = o[d0][r] * rli[r]; q += v * v; }
#pragma unroll
          for (int of = 1; of < 32; of <<= 1) q += __shfl_xor(q, of);
          if (r32t == 0) ssp[(size_t)crow(r, hit) * 16] = q; } }
#pragma unroll
    for (int r = 0; r < 16; ++r) { const int orow = crow(r, hit);
#pragma unroll
        for (int d0 = 0; d0 < 4; ++d0) { const float v = o[d0][r] * rli[r];
            const float vn = __shfl_xor(v, 1);
            if ((r32t & 1) == 0) *(unsigned*)(Ow + (size_t)orow * LDO + d0 * 32 + r32t) = cvt_pk_bf16(v, vn); } }
    S.jlo = jlo_n;
    __syncthreads();
#undef RESC
#undef KBASE
#undef QKT
#undef MASKT
#undef SEAM_K0
#undef HALF_STEP
}
#undef VMW
#undef VMWN
#undef AT_SLOAD
#undef AT_QLOAD
#undef LD16
#undef R_Q8
#undef R_K8
#undef R_KR8
#undef AT_SWRITE_K
#undef AT_SWRITE_V
#undef AT_SWRITE_VO
#undef R_TOK
#undef R_Q
#undef R_K
#undef R_V
#undef R_KR
#undef R_NC
#undef R_O
}

static_assert(att::LDS_BYTES <= RING_BYTES && pg8::STAGE_BYTES <= RING_BYTES && TAB_OFF + 72 * 4 <= LDS_BYTES, "LDS map");
struct Args { const float* in[19]; float* out; unsigned char* ws; int ph_lo, ph_hi; };
struct Frame {
    LAS unsigned char* lds; volatile LAS unsigned* MISC; gu32* ctl; unsigned char* ws;
    int tid, lane, wave, vcu, G;
};

template <int KT, int NT, bool FP8, class Map>
__device__ __forceinline__ void tr_tile(const float* W, int K, int N, void* WT, const float* gain, LAS float* scr, int item, int lane, Map dmap) {
    constexpr int LR = NT / 4, RPI = 64 / LR, NI = KT / RPI, P = NT + 1;
    const int nblk = (N + NT - 1) / NT, kb = item / nblk, nb = item % nblk, k0 = KT * kb, n0 = NT * nb;
    const int lr = lane / LR, lc = (lane % LR) * 4, cc = n0 + lc;
    f32x4 v[NI];
#pragma unroll
    for (int i = 0; i < NI; ++i) { v[i] = (f32x4){0.f, 0.f, 0.f, 0.f}; if (cc < N) v[i] = __builtin_nontemporal_load((const GAS f32x4*)(W + (size_t)(k0 + i * RPI + lr) * N + cc)); }
#pragma unroll
    for (int i = 0; i < NI; ++i) { const int kk = i * RPI + lr; float g = FP8 ? 64.f : 1.f; if (gain) g *= gain[k0 + kk];
        LAS float* d = scr + kk * P + lc; d[0] = v[i][0] * g; d[1] = v[i][1] * g; d[2] = v[i][2] * g; d[3] = v[i][3] * g; }
    LDS_WAIT(); asm volatile("" ::: "memory");
    const int c = lane & 7;
#pragma unroll
    for (int j = 0; j < NT / 8; ++j) { const int n = (lane >> 3) + 8 * j;
        if (n0 + n < N) { const int d = dmap(n0 + n);
            if (d >= 0) {
                if constexpr (FP8) { const LAS float* t = scr + (16 * c) * P + n; u32x4 o;
#pragma unroll
                    for (int q = 0; q < 4; ++q) { unsigned w = 0u; w = __builtin_amdgcn_cvt_pk_fp8_f32(t[(4 * q) * P], t[(4 * q + 1) * P], w, false); w = __builtin_amdgcn_cvt_pk_fp8_f32(t[(4 * q + 2) * P], t[(4 * q + 3) * P], w, true); o[q] = w; }
                    *(GAS u32x4*)((unsigned char*)WT + (size_t)d * K + k0 + 16 * c) = o; }
                else { const LAS float* t = scr + (8 * c) * P + n; u32x4 o; o.x = pk2(t[0 * P], t[1 * P]); o.y = pk2(t[2 * P], t[3 * P]); o.z = pk2(t[4 * P], t[5 * P]); o.w = pk2(t[6 * P], t[7 * P]);
                    *(GAS u32x4*)((bf16_t*)WT + (size_t)d * K + k0 + 8 * c) = o; } } } }
    LDS_WAIT(); asm volatile("" ::: "memory");
}
struct ExpItem { const float* W; unsigned char* WT; const float* gain; int N, k0, n0; bool gu; };
__device__ __forceinline__ void exp_load(const ExpItem& I, int lane, f32x4 (&v)[16]) {
    const int lr = lane >> 3, lc = (lane & 7) * 4;
#pragma unroll
    for (int i = 0; i < 16; ++i) v[i] = __builtin_nontemporal_load((const GAS f32x4*)(I.W + (size_t)(I.k0 + i * 8 + lr) * I.N + I.n0 + lc));
}
__device__ __forceinline__ void exp_finish(const ExpItem& I, int lane, LAS float* scr, const f32x4 (&v)[16]) {
    constexpr int P = 33; const int lr = lane >> 3, lc = (lane & 7) * 4;
#pragma unroll
    for (int i = 0; i < 16; ++i) { const int kk = i * 8 + lr; float g = 64.f; if (I.gain) g *= I.gain[I.k0 + kk];
        LAS float* d = scr + kk * P + lc; d[0] = v[i][0] * g; d[1] = v[i][1] * g; d[2] = v[i][2] * g; d[3] = v[i][3] * g; }
    LDS_WAIT(); asm volatile("" ::: "memory");
    const int c = lane & 7;
#pragma unroll
    for (int j = 0; j < 4; ++j) { const int n = (lane >> 3) + 8 * j, col = I.n0 + n; const int d = I.gu ? (((col & 2047) >> 7) * 256 + (col >> 11) * 128 + (col & 127)) : col;
        const LAS float* t = scr + (16 * c) * P + n; u32x4 o;
#pragma unroll
        for (int q = 0; q < 4; ++q) { unsigned w = 0u; w = __builtin_amdgcn_cvt_pk_fp8_f32(t[(4 * q) * P], t[(4 * q + 1) * P], w, false); w = __builtin_amdgcn_cvt_pk_fp8_f32(t[(4 * q + 2) * P], t[(4 * q + 3) * P], w, true); o[q] = w; }
        *(GAS u32x4*)(I.WT + (size_t)d * DM + I.k0 + 16 * c) = o; }
    LDS_WAIT(); asm volatile("" ::: "memory");
}
struct MapId { __device__ __forceinline__ int operator()(int c) const { return c; } };
struct MapWin {
    __device__ __forceinline__ int operator()(int c) const {
        if (c < 1024) return c;
        if (c < 1088) { const int i = c - 1024; return 4096 + (i < 32 ? 2 * i : 2 * (i - 32) + 1); }
        if (c < 4160) return c - 64;
        return 4160 + (c - 4160);
    }
};
struct MapWq {
    __device__ __forceinline__ int operator()(int c) const { const int h = c / 192, j = c % 192; if (j < 128) return c; const int i = j - 128; return h * 192 + 128 + (i < 32 ? 2 * i : 2 * (i - 32) + 1); }
};
struct MapGu {
    __device__ __forceinline__ int operator()(int c) const { const int f = c & 2047; return (f >> 7) * 256 + (c >> 11) * 128 + (f & 127); }
};

__device__ __forceinline__ void p0_prologue(Frame& F, const Args& a) {
    LAS float* scr = (LAS float*)(F.lds + F.wave * 16896);
    const int gw = F.vcu * NWAVES + F.wave, NGW = F.G * NWAVES;
    const float* x = a.in[0]; const float* g_attn = a.in[1]; const float* w_in = a.in[2]; const float* g_q_a = a.in[3]; const float* w_q_b = a.in[4];
    const float* g_kv_a = a.in[5]; const float* w_kv_b = a.in[6]; const float* g_mla = a.in[8]; const float* g_fox = a.in[9]; const float* w_o = a.in[10];
    const float* g_ffn = a.in[11]; const float* w_router = a.in[12]; const float* w_gu = a.in[14]; const float* w_dn = a.in[16];
    bf16_t* WIN = (bf16_t*)(F.ws + WS_WIN); bf16_t* WQB = (bf16_t*)(F.ws + WS_WQB); bf16_t* WKVB = (bf16_t*)(F.ws + WS_WKVB); bf16_t* WO = (bf16_t*)(F.ws + WS_WO);
    bf16_t* HN = (bf16_t*)(F.ws + WS_HN);
    constexpr int I_GU1 = USE_FP8 ? (DM / 128) * (4096 / 32) : (DM / 64) * (4096 / 64), I_GU = NE * I_GU1, I_DN1 = USE_FP8 ? (DM / 128) * (DM / 32) : (DM / 64) * (DM / 64), I_DN = NE * I_DN1;
    constexpr int I_IN = FP8D ? (DM / 128) * ((NIN + 31) / 32) : (DM / 64) * ((NIN + 63) / 64), I_QB = (512 / 64) * (QW / 64), I_KVB = (512 / 64) * (KVW / 64), I_O = FP8O ? (DM / 128) * (DM / 32) : (DM / 64) * (DM / 64);
    constexpr int NITEMS = I_GU + I_DN + I_IN + I_QB + I_KVB + I_O;
    constexpr int WB = USE_FP8 ? 1 : 2;
    unsigned char* WGU = F.ws + WS_WGU; unsigned char* WDN = F.ws + WS_WDN;
    if constexpr (USE_FP8) {
        auto decode = [&](int r) { ExpItem I; I.gu = r < I_GU; const int q = I.gu ? r : r - I_GU, per = I.gu ? I_GU1 : I_DN1, e = q / per, it = q % per; I.N = I.gu ? 4096 : DM;
            const int nblk = I.N / 32; I.k0 = 128 * (it / nblk); I.n0 = 32 * (it % nblk); I.W = (I.gu ? w_gu : w_dn) + (size_t)e * DM * I.N; I.WT = (I.gu ? WGU : WDN) + (size_t)e * I.N * DM; I.gain = I.gu ? g_ffn : nullptr; return I; };
        f32x4 va[16], vb[16]; int r = gw;
        if (r < I_GU + I_DN) exp_load(decode(r), F.lane, va);
        while (r < I_GU + I_DN) {
            const int r1 = r + NGW; if (r1 < I_GU + I_DN) exp_load(decode(r1), F.lane, vb);
            exp_finish(decode(r), F.lane, scr, va);
            if (r1 >= I_GU + I_DN) break;
            const int r2 = r1 + NGW; if (r2 < I_GU + I_DN) exp_load(decode(r2), F.lane, va);
            exp_finish(decode(r1), F.lane, scr, vb);
            r = r2;
        }
    }
    for (int it = gw + (USE_FP8 ? ((I_GU + I_DN - gw + NGW - 1) / NGW) * NGW : 0); it < NITEMS; it += NGW) {
        int r = it;
        if constexpr (!USE_FP8) {
        if (r < I_GU) { const int e = r / I_GU1; const float* src = w_gu + (size_t)e * DM * 4096; unsigned char* dst = WGU + (size_t)e * 4096 * DM * WB;
            tr_tile<64, 64, false>(src, DM, 4096, dst, g_ffn, scr, r % I_GU1, F.lane, MapGu()); continue; }
        if (r < I_GU + I_DN) { const int q = r - I_GU, e = q / I_DN1; const float* src = w_dn + (size_t)e * DM * DM; unsigned char* dst = WDN + (size_t)e * DM * DM * WB;
            tr_tile<64, 64, false>(src, DM, DM, dst, nullptr, scr, q % I_DN1, F.lane, MapId()); continue; }
        }
        r -= I_GU + I_DN;
        if (r < I_IN) { if constexpr (FP8D) tr_tile<128, 32, true>(w_in, DM, NIN, WIN, nullptr, scr, r, F.lane, MapWin()); else tr_tile<64, 64, false>(w_in, DM, NIN, WIN, nullptr, scr, r, F.lane, MapWin()); continue; } r -= I_IN;
        if (r < I_QB) { tr_tile<64, 64, false>(w_q_b, 512, QW, WQB, g_q_a, scr, r, F.lane, MapWq()); continue; } r -= I_QB;
        if (r < I_KVB) { tr_tile<64, 64, false>(w_kv_b, 512, KVW, WKVB, g_kv_a, scr, r, F.lane, MapId()); continue; } r -= I_KVB;
        if constexpr (FP8O) { const int kb = r / (DM / 32); tr_tile<128, 32, true>(w_o, DM, DM, WO, (128 * kb < 1024) ? g_mla + 0 : g_fox - 1024, scr, r, F.lane, MapId()); }
        else { const int kb = r / (DM / 64); tr_tile<64, 64, false>(w_o, DM, DM, WO, (64 * kb < 1024) ? g_mla + 0 : g_fox - 1024, scr, r, F.lane, MapId()); }
    }
    { const int gt = F.vcu * 512 + F.tid, NT_ = F.G * 512; u32x4 z = {0u, 0u, 0u, 0u};
      constexpr int EB = FP8D ? 1 : 2;
      for (int i = gt; i < (4352 - 4168) * DM * EB / 16; i += NT_) *(GAS u32x4*)((unsigned char*)WIN + (size_t)4168 * DM * EB + (size_t)i * 16) = z; }
    { const int gt = F.vcu * 512 + F.tid, NT_ = F.G * 512; float* WR = (float*)(F.ws + WS_WR);
      for (int i = gt; i < DM * NE; i += NT_) WR[i] = w_router[i] * g_ffn[i >> 5]; }
    { const int gt = F.vcu * 512 + F.tid, NT_ = F.G * 512; f32x2* RT = (f32x2*)(F.ws + WS_ROPE);
      const float invf = (float)exp2(-(double)(gt & 31) * (13.287712379549449 / 32.0));
      for (int i = gt; i < SEQ * 32; i += NT_) {
          const int pos = i >> 5;
          const float ang = (float)pos * invf;
          double rev = (double)ang * 0.15915494309189535; rev -= __builtin_floor(rev + 0.5);
          const double r = rev * 6.283185307179586, r2 = r * r;
          double sn = 1.0, cs = 1.0;
#pragma unroll
          for (int n = 13; n >= 1; --n) sn = 1.0 - sn * r2 * (1.0 / (double)((2 * n) * (2 * n + 1)));
#pragma unroll
          for (int n = 14; n >= 1; --n) cs = 1.0 - cs * r2 * (1.0 / (double)((2 * n - 1) * (2 * n)));
          RT[i] = (f32x2){(float)cs, (float)(sn * r)};
      } }
    for (int m = gw; m < T; m += NGW) {
        const GAS f32x4* xr = (const GAS f32x4*)(x + (size_t)m * DM) + F.lane;
        f32x4 v[8]; float s = 0.f;
#pragma unroll
        for (int j = 0; j < 8; ++j) { v[j] = xr[64 * j]; s += (v[j].x * v[j].x + v[j].y * v[j].y) + (v[j].z * v[j].z + v[j].w * v[j].w); }
        const float rstd = 1.f / sqrtf(wave_sum(s) * (1.f / DM) + EPS);
        GAS u32x2* o8 = (GAS u32x2*)(HN + (size_t)m * DM) + F.lane; GAS unsigned* o4 = (GAS unsigned*)((unsigned char*)HN + (size_t)m * DM) + F.lane;
#pragma unroll
        for (int j = 0; j < 8; ++j) { const f32x4 g = *((const GAS f32x4*)g_attn + 64 * j + F.lane); const f32x4 y = {v[j].x * rstd * g.x, v[j].y * rstd * g.y, v[j].z * rstd * g.z, v[j].w * rstd * g.w};
            if constexpr (FP8D) { unsigned w = 0u; w = __builtin_amdgcn_cvt_pk_fp8_f32(y[0], y[1], w, false); w = __builtin_amdgcn_cvt_pk_fp8_f32(y[2], y[3], w, true); o4[64 * j] = w; }
            else o8[64 * j] = (u32x2){pk2(y[0], y[1]), pk2(y[2], y[3])}; }
    }
}

using pg8::Unit; using pg8::uni; using pg8::ald;
typedef f32x4 Acc[2][2][4][2];
__device__ __forceinline__ u32x4 pack8v(f32x4 a, f32x4 b) { u32x4 w; w.x = cvt_pk_bf16(a[0], a[1]); w.y = cvt_pk_bf16(a[2], a[3]); w.z = cvt_pk_bf16(b[0], b[1]); w.w = cvt_pk_bf16(b[2], b[3]); return w; }
__device__ __forceinline__ f32x4 rope4(f32x4 v, f32x2 cs0, f32x2 cs1) {
    return (f32x4){v[0] * cs0.x - v[1] * cs0.y, v[1] * cs0.x + v[0] * cs0.y, v[2] * cs1.x - v[3] * cs1.y, v[3] * cs1.x + v[2] * cs1.y};
}
constexpr float WSC = FP8D ? 0.015625f : 1.f;
struct EpiP1 {
    static constexpr bool SIDE = false, SIDE2 = false, MIDK = false;
    static constexpr int NSTORE = 0;
    static constexpr bool PERM = true;
    bf16_t* PROJ; bf16_t* KR; float* FL; float* ssq; const f32x2* rope; float* nrmp;
    __device__ __forceinline__ void operator()(const Acc& acc, const Unit& u, int wr, int wc, int fr, int fq) const {
        const int row0 = u.pm * 256 + wr * 64 + fr;
        if (u.pn < 16) {
            const int col0 = u.pn * 256 + wc * 32 + 8 * fq;
#pragma unroll
            for (int ai = 0; ai < 2; ++ai)
#pragma unroll
                for (int m = 0; m < 4; ++m) { const int row = row0 + ai * 128 + m * 16; bf16_t* rowp = PROJ + (size_t)row * PW + col0; float sb[2];
#pragma unroll
                    for (int bj = 0; bj < 2; ++bj) { const f32x4 v0 = acc[ai][bj][m][0] * WSC, v1 = acc[ai][bj][m][1] * WSC;
                        sb[bj] = (v0[0] * v0[0] + v0[1] * v0[1]) + (v0[2] * v0[2] + v0[3] * v0[3]) + (v1[0] * v1[0] + v1[1] * v1[1]) + (v1[2] * v1[2] + v1[3] * v1[3]);
                        *(u32x4*)(rowp + bj * 128) = pack8v(v0, v1); }
                    if (u.pn < 4) { float s = sb[0] + sb[1]; s += __shfl_xor(s, 16); s += __shfl_xor(s, 32); if (fq == 0) ssq[((size_t)(u.pn >> 1) * T + row) * 8 + (u.pn & 1) * 4 + wc] = s; }
                    else if (u.pn < 12) {
#pragma unroll
                        for (int bj = 0; bj < 2; ++bj) { float t = sb[bj]; t += __shfl_xor(t, 16); t += __shfl_xor(t, 32);
                            if (fq == 0) nrmp[((((size_t)((u.pn - 4) >> 2) * T + row) * 8) + 2 * ((u.pn - 4) & 3) + bj) * 4 + wc] = t; } } }
        } else {
#pragma unroll
            for (int ai = 0; ai < 2; ++ai)
#pragma unroll
                for (int m = 0; m < 4; ++m) { const int row = row0 + ai * 128 + m * 16; const f32x4 v0 = acc[ai][0][m][0] * WSC, v1 = acc[ai][0][m][1] * WSC;
                    if (wc < 2) { const int c = wc * 32 + 8 * fq; const f32x2* rt = rope + (size_t)(row & (SEQ - 1)) * 32 + (c >> 1);
                        *(u32x2*)((unsigned char*)KR + (size_t)row * 64 + c) = pack8f8(rope4(v0, rt[0], rt[1]), rope4(v1, rt[2], rt[3])); }
                    else if (wc == 2 && fq == 0) { *(f32x4*)(FL + (size_t)row * 8) = v0; *(f32x4*)(FL + (size_t)row * 8 + 4) = v1; } }
        }
    }
};
struct EpiQ {
    static constexpr bool SIDE = false, SIDE2 = false, MIDK = false;
    static constexpr int NSTORE = 0;
    static constexpr bool PERM = true;
    bf16_t* Q; const float* ssq; const f32x2* rope;
    __device__ __forceinline__ void operator()(const Acc& acc, const Unit& u, int wr, int wc, int fr, int fq) const {
        const int row0 = u.pm * 256 + wr * 64 + fr, col0 = u.pn * 256 + wc * 32 + 8 * fq;
#pragma unroll
        for (int ai = 0; ai < 2; ++ai)
#pragma unroll
            for (int m = 0; m < 4; ++m) { const int row = row0 + ai * 128 + m * 16; const f32x4 sa = *(const f32x4*)(ssq + (size_t)row * 8), sb = *(const f32x4*)(ssq + (size_t)row * 8 + 4);
                const float rs = 1.f / sqrtf((((sa[0] + sa[1]) + (sa[2] + sa[3])) + ((sb[0] + sb[1]) + (sb[2] + sb[3]))) * (1.f / 512.f) + EPS);
#pragma unroll
                for (int bj = 0; bj < 2; ++bj) { const int c = col0 + bj * 128, j = c % 192; f32x4 v0 = acc[ai][bj][m][0] * rs, v1 = acc[ai][bj][m][1] * rs;
                    if (j >= 128) { const f32x2* rt = rope + (size_t)(row & (SEQ - 1)) * 32 + ((j - 128) >> 1); v0 = rope4(v0, rt[0], rt[1]); v1 = rope4(v1, rt[2], rt[3]); }
                    *(u32x2*)((unsigned char*)Q + (size_t)row * QW + c) = pack8f8(v0, v1); } }
    }
};
struct EpiKV {
    static constexpr bool SIDE = false, SIDE2 = false, MIDK = false;
    static constexpr int NSTORE = 0;
    static constexpr bool PERM = true;
    bf16_t* KV; const float* ssq; unsigned char* K8;
    __device__ __forceinline__ void operator()(const Acc& acc, const Unit& u, int wr, int wc, int fr, int fq) const {
        const int row0 = u.pm * 256 + wr * 64 + fr, col0 = u.pn * 256 + wc * 32 + 8 * fq;
#pragma unroll
        for (int ai = 0; ai < 2; ++ai)
#pragma unroll
            for (int m = 0; m < 4; ++m) { const int row = row0 + ai * 128 + m * 16; const f32x4 sa = *(const f32x4*)(ssq + (size_t)row * 8), sb = *(const f32x4*)(ssq + (size_t)row * 8 + 4);
                const float rs = 1.f / sqrtf((((sa[0] + sa[1]) + (sa[2] + sa[3])) + ((sb[0] + sb[1]) + (sb[2] + sb[3]))) * (1.f / 512.f) + EPS);
                *(u32x2*)(K8 + (size_t)row * 1024 + u.pn * 128 + wc * 32 + 8 * fq) = pack8f8(acc[ai][0][m][0] * rs, acc[ai][0][m][1] * rs);
                *(u32x4*)(KV + (size_t)row * KVW + col0 + 128) = pack8v(acc[ai][1][m][0] * rs, acc[ai][1][m][1] * rs); }
    }
};
struct EpiWo {
    static constexpr bool SIDE = true, SIDE2 = true, MIDK = true;
    static constexpr int NSTORE = 0;
    static constexpr bool PERM = true;
    const float* x; float* H1; unsigned char* XB; const float* RR;
    __device__ __forceinline__ void side_load(unsigned (&d)[2], const Unit& u, int t) const { ald(d[0], uni((const char*)RR), (unsigned)(u.pm * 256 + t) * 8u); ald(d[1], uni((const char*)RR), (unsigned)(u.pm * 256 + t) * 8u + 4u); }
    __device__ __forceinline__ void midk(Acc& acc, int wr, int fr, const LAS float* tab) const {
#pragma unroll
        for (int ai = 0; ai < 2; ++ai)
#pragma unroll
            for (int m = 0; m < 4; ++m) { const float rt = tab[wr * 64 + fr + ai * 128 + m * 16];
#pragma unroll
                for (int bj = 0; bj < 2; ++bj) { acc[ai][bj][m][0] *= rt; acc[ai][bj][m][1] *= rt; } }
    }
    __device__ __forceinline__ void operator()(const Acc& acc, const Unit& u, int wr, int wc, int fr, int fq, const LAS float* tab) const {
        const int row0 = u.pm * 256 + wr * 64 + fr, col0 = u.pn * 256 + wc * 32 + 8 * fq;
        f32x4 xa[4][2][2];
#define EW_LOAD(X, ai) do { _Pragma("unroll") for (int m = 0; m < 4; ++m) { const size_t off = (size_t)(row0 + (ai) * 128 + m * 16) * DM + col0; \
            _Pragma("unroll") for (int bj = 0; bj < 2; ++bj) { X[m][bj][0] = *(const f32x4*)(x + off + bj * 128); X[m][bj][1] = *(const f32x4*)(x + off + bj * 128 + 4); } } } while (0)
#define EW_ADD(X, ai) do { _Pragma("unroll") for (int m = 0; m < 4; ++m) { const float rf = tab[256 + wr * 64 + fr + (ai) * 128 + m * 16] * (FP8O ? 0.015625f : 1.f); \
            _Pragma("unroll") for (int bj = 0; bj < 2; ++bj) { X[m][bj][0] += acc[ai][bj][m][0] * rf; X[m][bj][1] += acc[ai][bj][m][1] * rf; } } } while (0)
#define EW_STORE(X, ai) do { _Pragma("unroll") for (int m = 0; m < 4; ++m) { const size_t off = (size_t)(row0 + (ai) * 128 + m * 16) * DM + col0; \
            _Pragma("unroll") for (int bj = 0; bj < 2; ++bj) { *(f32x4*)(H1 + off + bj * 128) = X[m][bj][0]; *(f32x4*)(H1 + off + bj * 128 + 4) = X[m][bj][1]; \
                if constexpr (USE_FP8) *(u32x2*)(XB + off + bj * 128) = pack8f8(X[m][bj][0], X[m][bj][1]); else *(u32x4*)(XB + 2 * (off + bj * 128)) = pack8v(X[m][bj][0], X[m][bj][1]); } } } while (0)
        EW_LOAD(xa, 0); asm volatile("" ::: "memory");
        EW_ADD(xa, 0);  EW_STORE(xa, 0); asm volatile("" ::: "memory");
        EW_LOAD(xa, 1); asm volatile("" ::: "memory");
        EW_ADD(xa, 1);  EW_STORE(xa, 1);
#undef EW_LOAD
#undef EW_ADD
#undef EW_STORE
    }
};
__device__ __forceinline__ f32x2 swiglu2(f32x2 g, f32x2 u1) {
    g = __builtin_elementwise_min(g, (f32x2){7.f, 7.f});
    u1 = __builtin_elementwise_min(__builtin_elementwise_max(u1, (f32x2){-6.f, -6.f}), (f32x2){8.f, 8.f});
    const f32x2 t = g * (f32x2){-1.702f * 1.4426950408889634f, -1.702f * 1.4426950408889634f};
    const f32x2 d = (f32x2){__builtin_amdgcn_exp2f(t.x), __builtin_amdgcn_exp2f(t.y)} + (f32x2){1.f, 1.f};
    const f32x2 sg = {__builtin_amdgcn_rcpf(d.x), __builtin_amdgcn_rcpf(d.y)};
    return (g * sg) * u1;
}
__device__ __forceinline__ float swiglu1(float g, float u) {
    g = fminf(g, 7.f); u = fminf(fmaxf(u, -7.f), 7.f);
    const float sg = __builtin_amdgcn_rcpf(1.f + __builtin_amdgcn_exp2f(-1.702f * 1.4426950408889634f * g));
    return g * sg * (u + 1.f);
}
struct EpiGU {
    static constexpr bool SIDE = true, SIDE2 = true, MIDK = false;
    static constexpr int NSTORE = 8;
    static constexpr bool PERM = true;
    unsigned char* H; const float* bgu; const float* listr; const LAS int* tstart;
    __device__ __forceinline__ void side_load(unsigned (&d)[2], const Unit& u, int t) const {
        ald(d[0], uni((const char*)bgu), (unsigned)(u.e * 4096 + (t >> 7) * 2048 + u.pn * 128 + (t & 127)) * 4u); ald(d[1], uni((const char*)listr), (unsigned)(u.e * LIST_CAP + (u.pm - tstart[u.e]) * 256 + t) * 4u); }
    __device__ __forceinline__ void operator()(const Acc& acc, const Unit& u, int wr, int wc, int fr, int fq, const LAS float* tab) const {
        const int c0 = wc * 32 + 8 * fq, f0 = u.pn * 128 + c0;
        const f32x4 bg0 = *(const LAS f32x4*)(tab + c0), bg1 = *(const LAS f32x4*)(tab + c0 + 4), bu0 = *(const LAS f32x4*)(tab + 128 + c0) + 1.f, bu1 = *(const LAS f32x4*)(tab + 128 + c0 + 4) + 1.f;
#define GU_LO(v) __builtin_shufflevector(v, v, 0, 1)
#define GU_HI(v) __builtin_shufflevector(v, v, 2, 3)
#pragma unroll
        for (int ai = 0; ai < 2; ++ai)
#pragma unroll
            for (int m = 0; m < 4; ++m) { const int lr = wr * 64 + fr + ai * 128 + m * 16; const float rs = tab[256 + lr] * (USE_FP8 ? 0.015625f : 1.f); const f32x2 rs2 = {rs, rs};
                const f32x2 ha = swiglu2(GU_LO(acc[ai][0][m][0]) * rs2 + GU_LO(bg0), GU_LO(acc[ai][1][m][0]) * rs2 + GU_LO(bu0)), hb = swiglu2(GU_HI(acc[ai][0][m][0]) * rs2 + GU_HI(bg0), GU_HI(acc[ai][1][m][0]) * rs2 + GU_HI(bu0));
                const f32x2 hc = swiglu2(GU_LO(acc[ai][0][m][1]) * rs2 + GU_LO(bg1), GU_LO(acc[ai][1][m][1]) * rs2 + GU_LO(bu1)), hd = swiglu2(GU_HI(acc[ai][0][m][1]) * rs2 + GU_HI(bg1), GU_HI(acc[ai][1][m][1]) * rs2 + GU_HI(bu1));
                const f32x4 h0 = __builtin_shufflevector(ha, hb, 0, 1, 2, 3), h1 = __builtin_shufflevector(hc, hd, 0, 1, 2, 3);
                const size_t ho = (size_t)(u.pm * 256 + lr) * DM + f0;
                if constexpr (USE_FP8) *(u32x2*)(H + ho) = pack8f8(h0, h1); else *(u32x4*)(H + 2 * ho) = pack8v(h0, h1); }
    }
};
struct EpiDn {
    static constexpr bool SIDE = true, SIDE2 = false, MIDK = false;
    static constexpr int NSTORE = 16;
    static constexpr bool PERM = true;
    unsigned char* Y; const float* bdn;
    __device__ __forceinline__ void side_load(unsigned (&d)[2], const Unit& u, int t) const { ald(d[0], uni((const char*)bdn), (unsigned)(u.e * DM + u.pn * 256 + t) * 4u); }
    __device__ __forceinline__ void operator()(const Acc& acc, const Unit& u, int wr, int wc, int fr, int fq, const LAS float* tab) const {
        const int row0 = u.pm * 256 + wr * 64 + fr, c0 = wc * 32 + 8 * fq, col0 = u.pn * 256 + c0;
        f32x4 bv[2][2];
#pragma unroll
        for (int bj = 0; bj < 2; ++bj)
#pragma unroll
            for (int n = 0; n < 2; ++n) bv[bj][n] = *(const LAS f32x4*)(tab + c0 + bj * 128 + 4 * n);
        constexpr float SC = (USE_FP8 ? 0.015625f : 1.f) * (MK_DUP == 101 ? 0.5f : 1.f);
#pragma unroll
        for (int ai = 0; ai < 2; ++ai)
#pragma unroll
            for (int m = 0; m < 4; ++m) { unsigned char* rowp = Y + (size_t)(row0 + ai * 128 + m * 16) * DM + col0;
#pragma unroll
                for (int bj = 0; bj < 2; ++bj) *(u32x2*)(rowp + bj * 128) = pack8f8(acc[ai][bj][m][0] * SC + bv[bj][0], acc[ai][bj][m][1] * SC + bv[bj][1]); }
    }
};

__device__ __forceinline__ void p2_cumsum(Frame& F, const Args& a) {
    const float* FL = (const float*)(F.ws + WS_FL); float* NC = (float*)(F.ws + WS_CUM); const float* b_forget = a.in[7];
    LAS double* part = (LAS double*)F.lds;
    for (int sq = F.vcu; sq < NB * 8; sq += F.G) {
        const int b = sq >> 3, h = sq & 7; const float bf = b_forget[h];
        const float* src = FL + ((size_t)b * SEQ + (size_t)F.tid * 16) * 8 + h;
        float lv[16]; double run = 0.0;
#pragma unroll
        for (int j = 0; j < 16; ++j) lv[j] = src[(size_t)j * 8];
#pragma unroll
        for (int j = 0; j < 16; ++j) { const float xx = lv[j] + bf; lv[j] = fminf(xx, 0.f) - __logf(1.f + __expf(-fabsf(xx))); run += (double)lv[j]; }
        double incl = run;
#pragma unroll
        for (int o = 1; o < 64; o <<= 1) { const double up = __shfl_up(incl, o); if (F.lane >= o) incl += up; }
        if (F.lane == 63) part[F.wave] = incl;
        __syncthreads();
        double acc = incl - run;
        for (int w = 0; w < F.wave; ++w) acc += part[w];
        float* dst = NC + (size_t)sq * SEQ + (size_t)F.tid * 16;
#pragma unroll
        for (int j = 0; j < 16; ++j) { acc += (double)lv[j]; dst[j] = (float)(-11.313708498984761 * acc); }
        __syncthreads();
    }
}

__device__ __forceinline__ void p2_norms(Frame& F) {
    const f32x4* NP = (const f32x4*)(F.ws + WS_NRMP); gu32* nrm = F.ctl + CW_NRM;
    LAS float* red = (LAS float*)(F.lds + 1024);
    const int hs = F.lane & 15, sub = F.lane >> 4;
    constexpr int RPW = 16, RPG = RPW * NWAVES;
    for (int r0 = F.vcu * RPG; r0 < T; r0 += F.G * RPG) {
        float m = 0.f;
#pragma unroll
        for (int k = 0; k < RPW / 4; ++k) { const int row = r0 + F.wave * RPW + 4 * k + sub;
            const f32x4 v = NP[((size_t)(hs >> 3) * T + row) * 8 + (hs & 7)]; m = fmaxf(m, (v[0] + v[1]) + (v[2] + v[3])); }
        m = fmaxf(m, __shfl_xor(m, 16)); m = fmaxf(m, __shfl_xor(m, 32));
        if (F.lane < 16) red[F.wave * 16 + hs] = m;
        __syncthreads();
        if (F.tid < 16) { float mm = red[F.tid];
#pragma unroll
            for (int w = 1; w < NWAVES; ++w) mm = fmaxf(mm, red[w * 16 + F.tid]);
            const int bh = (r0 / SEQ) * 8 + (F.tid & 7);
            __hip_atomic_fetch_max(nrm + (F.tid < 8 ? 0 : 32) + bh, __builtin_bit_cast(unsigned, mm), RLX_AGENT); }
        __syncthreads();
    }
}

template <int DK, bool BIAS, int LDQ, int LDK, int LDV>
__device__ __forceinline__ void attn_group(Frame& F, char* lds, const bf16_t* Qb, int qhs, const bf16_t* Kb, const bf16_t* Vb, int khs, const bf16_t* KRb, const float* NCb, bf16_t* Ob, int slot0) {
    const gu32* nrm = F.ctl + CW_NRM;
    const int nquad = (256 - F.vcu + F.G - 1) / F.G; if (nquad <= 0) return;
    const int nblk = nquad * 4;
    const att::Group G{Qb, Kb, Vb, KRb, NCb, Ob, (float*)(F.ws + WS_SS), qhs, khs, slot0};
    auto ref = [&](int i) { att::BlockRef R; const int quad = F.vcu + (i >> 2) * F.G, s = quad & 7, j = i & 3;
        R.bh = quad >> 3; if constexpr (BIAS) R.bh = (R.bh & ~7) | ((R.bh + 2 * j) & 7);
        R.P0 = 256 * ((j == 0) ? s : (j == 1) ? 15 - s : (j == 2) ? 16 + s : 31 - s); R.W = 0.f;
        if constexpr (BIAS) R.W = 2.f * sqrtf(__builtin_bit_cast(float, __hip_atomic_load(nrm + R.bh, RLX_AGENT)) * __builtin_bit_cast(float, __hip_atomic_load(nrm + 32 + R.bh, RLX_AGENT))) * 1.005f + 30.f * 11.313708498984761f;
        return R; };
    att::Seam<DK> S;
    att::BlockRef cur = ref(0);
    att::prime<DK, BIAS, LDQ, LDK, LDV>(G, cur, lds, S);
    for (int i = 0; i < nblk; ++i) {
        const att::BlockRef nxt = (i + 1 < nblk) ? ref(i + 1) : cur;
        att::block<DK, BIAS, LDQ, LDK, LDV>(G, cur, nxt, lds, S);
        cur = nxt;
    }
    VM_WAIT(); __syncthreads();
}

__device__ __forceinline__ void onorm_tile(Frame& F, int pm, int t256) {
    const f32x4* SS = (const f32x4*)(F.ws + WS_SS); f32x2* RR = (f32x2*)(F.ws + WS_RR);
    const int t = pm * 256 + t256;
    const f32x4 a = SS[t * 4], b = SS[t * 4 + 1], c = SS[t * 4 + 2], d = SS[t * 4 + 3];
    const float rm = 1.f / sqrtf((((a[0] + a[1]) + (a[2] + a[3])) + ((b[0] + b[1]) + (b[2] + b[3]))) * (1.f / 1024.f) + EPS);
    const float rf = 1.f / sqrtf((((c[0] + c[1]) + (c[2] + c[3])) + ((d[0] + d[1]) + (d[2] + d[3]))) * (1.f / 1024.f) + EPS);
    RR[t] = (f32x2){rm / rf, rf};
}
__device__ __forceinline__ void p4_onorm(Frame& F) {
    const f32x4* SS = (const f32x4*)(F.ws + WS_SS); f32x2* RR = (f32x2*)(F.ws + WS_RR);
    for (int t = F.vcu * 512 + F.tid; t < T; t += F.G * 512) {
        const f32x4 a = SS[t * 4], b = SS[t * 4 + 1], c = SS[t * 4 + 2], d = SS[t * 4 + 3];
        const float rm = 1.f / sqrtf((((a[0] + a[1]) + (a[2] + a[3])) + ((b[0] + b[1]) + (b[2] + b[3]))) * (1.f / 1024.f) + EPS);
        const float rf = 1.f / sqrtf((((c[0] + c[1]) + (c[2] + c[3])) + ((d[0] + d[1]) + (d[2] + d[3]))) * (1.f / 1024.f) + EPS);
        RR[t] = (f32x2){rm / rf, rf};
    }
}

__device__ __forceinline__ void p6_router(Frame& F, const Args& a) {
    const float* H1 = a.out; const float* WR = (const float*)(F.ws + WS_WR); const float* b_router = a.in[13];
    int* RE = (int*)(F.ws + WS_RE); int* RP = (int*)(F.ws + WS_RP); float* RG = (float*)(F.ws + WS_RG); int* LIST = (int*)(F.ws + WS_LIST); float* LISTR = (float*)(F.ws + WS_LISTR);
    gu32* cnt = F.ctl + CW_CNT;
    LAS float* part = (LAS float*)F.lds;
    LAS float* ssqp = (LAS float*)(F.lds + 8 * 32 * 33 * 4);
    LAS int* lcnt = (LAS int*)(F.lds + 8 * 32 * 33 * 4 + 2048);
    LAS int* lbase = lcnt + 32;
    const int w = F.wave, r = F.lane & 31, hh = F.lane >> 5;
    float bw[128];
#pragma unroll
    for (int j = 0; j < 32; ++j)
#pragma unroll
        for (int i = 0; i < 4; ++i) bw[j * 4 + i] = WR[(size_t)(256 * w + 8 * j + 4 * hh + i) * 32 + r];
    if (F.tid < 32) lcnt[F.tid] = 0;
    __syncthreads();
    for (int tile = F.vcu; tile < T / 32; tile += F.G) {
        const int tok0 = tile * 32;
        const float* xr = H1 + (size_t)(tok0 + r) * DM + 256 * w + 4 * hh;
        f32x16 acc = {}; float ssq = 0.f;
#pragma unroll
        for (int jb = 0; jb < 4; ++jb) { f32x4 av[8];
#pragma unroll
            for (int jj = 0; jj < 8; ++jj) av[jj] = *(const f32x4*)(xr + 8 * (8 * jb + jj));
#pragma unroll
            for (int jj = 0; jj < 8; ++jj)
#pragma unroll
                for (int i = 0; i < 4; ++i) { acc = __builtin_amdgcn_mfma_f32_32x32x2f32(av[jj][i], bw[(8 * jb + jj) * 4 + i], acc, 0, 0, 0); ssq += av[jj][i] * av[jj][i]; } }
#pragma unroll
        for (int q = 0; q < 16; ++q) part[(w * 32 + ((q & 3) + 8 * (q >> 2) + 4 * hh)) * 33 + r] = acc[q];
        ssqp[(w * 2 + hh) * 32 + r] = ssq;
        __syncthreads();
        int my_e[2] = {0, 0}, my_rank[2] = {0, 0}; float my_g[2] = {0.f, 0.f}, my_rs[2] = {0.f, 0.f};
#pragma unroll
        for (int ps = 0; ps < 2; ++ps) {
            const int tl = 4 * w + 2 * ps + hh;
            float s = 0.f, lg = 0.f;
#pragma unroll
            for (int ww = 0; ww < 8; ++ww) { lg += part[(ww * 32 + tl) * 33 + r]; s += ssqp[(ww * 2 + 0) * 32 + tl] + ssqp[(ww * 2 + 1) * 32 + tl]; }
            const float rs = 1.f / sqrtf(s * (1.f / DM) + EPS);
            lg = lg * rs + b_router[r];
            float tv[4]; int ti[4]; float cur = lg;
#pragma unroll
            for (int k = 0; k < 4; ++k) { float bv = cur; int bi = r;
#pragma unroll
                for (int o = 1; o < 32; o <<= 1) { const float ov = __shfl_xor(bv, o); const int oi = __shfl_xor(bi, o); if (ov > bv || (ov == bv && oi < bi)) { bv = ov; bi = oi; } }
                tv[k] = bv; ti[k] = bi; if (r == bi) cur = -__builtin_inff(); }
            const float e1 = __expf(tv[1] - tv[0]), e2 = __expf(tv[2] - tv[0]), e3 = __expf(tv[3] - tv[0]); const float inv = 1.f / (1.f + e1 + e2 + e3);
            if (r < 4) { my_e[ps] = ti[r]; my_g[ps] = (r == 0 ? 1.f : r == 1 ? e1 : r == 2 ? e2 : e3) * inv; my_rs[ps] = rs;
                my_rank[ps] = __hip_atomic_fetch_add(lcnt + ti[r], 1, __ATOMIC_RELAXED, __HIP_MEMORY_SCOPE_WORKGROUP); }
        }
        __syncthreads();
        if (F.tid < 32) { const int n = lcnt[F.tid]; lbase[F.tid] = n ? (int)__hip_atomic_fetch_add(cnt + 64 * F.tid, (unsigned)n, RLX_AGENT) : 0; lcnt[F.tid] = 0; }
        __syncthreads();
        if (r < 4) {
#pragma unroll
            for (int ps = 0; ps < 2; ++ps) { const int t = tok0 + 4 * w + 2 * ps + hh, e = my_e[ps], pos = lbase[e] + my_rank[ps];
                RE[t * 4 + r] = e; RP[t * 4 + r] = pos; RG[t * 4 + r] = my_g[ps];
                LIST[(size_t)e * LIST_CAP + pos] = t; LISTR[(size_t)e * LIST_CAP + pos] = my_rs[ps]; }
        }
        __syncthreads();
    }
}

__device__ __forceinline__ void moe_tables(Frame& F) {
    LAS int* tstart = (LAS int*)(F.lds + TAB_OFF);
    if (F.tid < 64) {
        const int e = F.tid & 31; const int n = (int)__hip_atomic_load(F.ctl + CW_CNT + 64 * e, RLX_AGENT); const int tiles = (n + 255) >> 8;
        int incl = tiles;
#pragma unroll
        for (int o = 1; o < 32; o <<= 1) { const int v = __shfl_up(incl, o, 32); if (e >= o) incl += v; }
        if (F.tid < 32) { tstart[e] = incl - tiles; tstart[40 + e] = n; if (e == NE - 1) tstart[NE] = incl; } }
    __syncthreads();
}

__device__ __forceinline__ void p9_final(Frame& F, const Args& a) {
    const LAS int* tstart = (const LAS int*)(F.lds + TAB_OFF);
    const int* RE = (const int*)(F.ws + WS_RE); const int* RP = (const int*)(F.ws + WS_RP); const float* RG = (const float*)(F.ws + WS_RG);
    const unsigned char* YK = F.ws + WS_YK; const float* g_final = a.in[18]; float* out = a.out;
    const int gw = F.vcu * NWAVES + F.wave, NGW = F.G * NWAVES;
    f32x4 gf[8];
#pragma unroll
    for (int j = 0; j < 4; ++j) { gf[2 * j] = *((const GAS f32x4*)g_final + (64 * j + F.lane) * 2); gf[2 * j + 1] = *((const GAS f32x4*)g_final + (64 * j + F.lane) * 2 + 1); }
    i32x4 e4 = {0, 0, 0, 0}, p4 = {0, 0, 0, 0}; f32x4 g4 = {0.f, 0.f, 0.f, 0.f};
    if (gw < T) { e4 = ((const i32x4*)RE)[gw]; p4 = ((const i32x4*)RP)[gw]; g4 = ((const f32x4*)RG)[gw]; }
    for (int m = gw; m < T; m += NGW) {
        const GAS u32x2* yp[4];
#pragma unroll
        for (int k = 0; k < 4; ++k) yp[k] = (const GAS u32x2*)(YK + (size_t)(tstart[e4[k]] * 256 + p4[k]) * DM) + F.lane;
        GAS f32x4* xr = (GAS f32x4*)(out + (size_t)m * DM);
        f32x4 y[8]; u32x2 wv[4][4];
#pragma unroll
        for (int j = 0; j < 4; ++j) { y[2 * j] = xr[(64 * j + F.lane) * 2]; y[2 * j + 1] = xr[(64 * j + F.lane) * 2 + 1];
#pragma unroll
            for (int k = 0; k < 4; ++k) wv[j][k] = yp[k][64 * j]; }
        const f32x4 gk = g4;
        { const int mn = m + NGW; if (mn < T) { e4 = ((const i32x4*)RE)[mn]; p4 = ((const i32x4*)RP)[mn]; g4 = ((const f32x4*)RG)[mn]; } }
        float s = 0.f;
#pragma unroll
        for (int j = 0; j < 4; ++j) { f32x4 a0 = y[2 * j], a1 = y[2 * j + 1];
#pragma unroll
            for (int k = 0; k < 4; ++k) { const u32x2 w = wv[j][k];
                const f32x2 c0 = __builtin_amdgcn_cvt_pk_f32_fp8(w.x, false), c1 = __builtin_amdgcn_cvt_pk_f32_fp8(w.x, true), c2 = __builtin_amdgcn_cvt_pk_f32_fp8(w.y, false), c3 = __builtin_amdgcn_cvt_pk_f32_fp8(w.y, true);
                a0 += gk[k] * (f32x4){c0.x, c0.y, c1.x, c1.y}; a1 += gk[k] * (f32x4){c2.x, c2.y, c3.x, c3.y}; }
            y[2 * j] = a0; y[2 * j + 1] = a1;
            s += (a0.x * a0.x + a0.y * a0.y) + (a0.z * a0.z + a0.w * a0.w) + (a1.x * a1.x + a1.y * a1.y) + (a1.z * a1.z + a1.w * a1.w); }
        const float rstd = 1.f / sqrtf(wave_sum(s) * (1.f / DM) + EPS);
#pragma unroll
        for (int j = 0; j < 4; ++j) { xr[(64 * j + F.lane) * 2] = y[2 * j] * rstd * gf[2 * j]; xr[(64 * j + F.lane) * 2 + 1] = y[2 * j + 1] * rstd * gf[2 * j + 1]; }
    }
}
__device__ __forceinline__ void dbg_final_norm(Frame& F, const Args& a, const float* src) {
    const float* g_final = a.in[18]; float* out = a.out; const int gw = F.vcu * NWAVES + F.wave, NGW = F.G * NWAVES;
    for (int m = gw; m < T; m += NGW) {
        const GAS f32x4* xr = (const GAS f32x4*)(src + (size_t)m * DM) + F.lane; GAS f32x4* orow = (GAS f32x4*)(out + (size_t)m * DM) + F.lane;
        f32x4 v[8]; float s = 0.f;
#pragma unroll
        for (int j = 0; j < 8; ++j) { v[j] = xr[64 * j]; s += (v[j].x * v[j].x + v[j].y * v[j].y) + (v[j].z * v[j].z + v[j].w * v[j].w); }
        const float rstd = 1.f / sqrtf(wave_sum(s) * (1.f / DM) + EPS);
#pragma unroll
        for (int j = 0; j < 8; ++j) orow[64 * j] = v[j] * rstd * *((const GAS f32x4*)g_final + 64 * j + F.lane);
    }
}

__global__ void __launch_bounds__(NWAVES * 64, 2) mk_fwd(Args args) {
    extern __shared__ __attribute__((aligned(16))) unsigned char lds[];
    Frame F;
    F.lds = (LAS unsigned char*)lds; F.MISC = (volatile LAS unsigned*)(F.lds + MISC_OFF);
    F.tid = threadIdx.x; F.lane = F.tid & 63; F.wave = __builtin_amdgcn_readfirstlane(F.tid >> 6);
    F.G = gridDim.x; { const int bx = blockIdx.x; F.vcu = (F.G % 8 == 0) ? (bx % 8) * (F.G / 8) + bx / 8 : bx; }
    F.ws = args.ws; F.ctl = (gu32*)(args.ws + WS_CTL);
    for (int u = F.tid; u < (LDS_BYTES - LDSCTL_OFF) / 4; u += NWAVES * 64) ((LAS unsigned*)(F.lds + LDSCTL_OFF))[u] = 0u;
    __syncthreads();
    XcdBarrier bar; bar.bar = (unsigned*)(F.ctl + CW_BAR); bar.x = 0; bar.st = nullptr;
#if MK_ONE_LAUNCH
    bar = xcd_barrier_post((unsigned*)(F.ctl + CW_BAR), F.MISC + 8);
#define GRID_BAR() xcd_barrier(bar)
#else
#define GRID_BAR() do { } while (0)
#endif
    const int lo = args.ph_lo, hi = args.ph_hi;
#ifndef MK_PHASE_MASK
#define MK_PHASE_MASK 0xffffffffu
#endif
#define IN(k) (((MK_PHASE_MASK >> (k)) & 1u) && lo <= (k) && (k) < hi)
#define BOTH(k) (IN(k) && IN((k) + 1))
    unsigned char* ws = args.ws;
    bf16_t* PROJ = (bf16_t*)(ws + WS_PROJ); float* ssq = (float*)(ws + WS_SSQ); const f32x2* rope = (const f32x2*)(ws + WS_ROPE);
    LAS int* tstart = (LAS int*)(F.lds + TAB_OFF);

#ifdef MK_TPROBE
#define STAMP(k) do { if (blockIdx.x == 0 && F.tid == 0) ((unsigned long long*)(ws + 21 * MiB))[k] = __builtin_amdgcn_s_memrealtime(); } while (0)
#else
#define STAMP(k) do { } while (0)
#endif
    STAMP(0);
    if (IN(0)) { p0_prologue(F, args); if (MK_DUP == 0) { GRID_BAR(); p0_prologue(F, args); } if (BOTH(0)) GRID_BAR(); }
    STAMP(1);
    if (IN(1)) {
        pg8::DenseSched S; S.o.init(T / 256, 17, F.G, (int)blockIdx.x); S.A = ws + WS_HN; S.Bt = ws + WS_WIN; S.lda = DM * (FP8D ? 1 : 2); S.ldb = S.lda;
        EpiP1 E{PROJ, (bf16_t*)(ws + WS_KR8), (float*)(ws + WS_FL), ssq, rope, (float*)(ws + WS_NRMP)};
        pg8::gemm_phase<EpiP1, pg8::DenseSched, false, FP8D>(F.lds, S.lda, S, E);
        if (MK_DUP == 1) { GRID_BAR(); pg8::gemm_phase<EpiP1, pg8::DenseSched, false, FP8D>(F.lds, S.lda, S, E); }
        if (BOTH(1)) GRID_BAR();
    }
    STAMP(2);
    if (IN(2)) {
        p2_cumsum(F, args); p2_norms(F); __syncthreads();
        { pg8::DenseSched S; S.o.init(T / 256, QW / 256, F.G, (int)blockIdx.x); S.A = PROJ; S.Bt = ws + WS_WQB; S.lda = PW * 2; S.ldb = 1024;
          EpiQ E{(bf16_t*)(ws + WS_QB), ssq, rope};
          pg8::gemm_phase<EpiQ, pg8::DenseSched, false>(F.lds, 1024, S, E); }
        { pg8::DenseSched S; S.o.init(T / 256, KVW / 256, F.G, (int)blockIdx.x); S.A = PROJ + 512; S.Bt = ws + WS_WKVB; S.lda = PW * 2; S.ldb = 1024;
          EpiKV E{(bf16_t*)(ws + WS_KV), ssq + (size_t)T * 8, ws + WS_K8};
          pg8::gemm_phase<EpiKV, pg8::DenseSched, false>(F.lds, 1024, S, E); }
        if (BOTH(2)) GRID_BAR();
    }
    STAMP(3);
    if (IN(3)) {
        const bf16_t* KV = (const bf16_t*)(ws + WS_KV); bf16_t* O = (bf16_t*)(ws + WS_O);
#define P3_BODY() do { \
        attn_group<192, false, QW, KVW, KVW>(F, (char*)lds, (const bf16_t*)(ws + WS_QB), 192, (const bf16_t*)(ws + WS_K8), KV + 128, 256, (const bf16_t*)(ws + WS_KR8), nullptr, O, 0); \
        attn_group<128, true, PW, PW, PW>(F, (char*)lds, PROJ + 1024, 128, PROJ + 2048, PROJ + 3072, 128, nullptr, (const float*)(ws + WS_CUM), O + 1024, 8); } while (0)
        P3_BODY();
        if (MK_DUP == 3) { GRID_BAR(); P3_BODY(); }
        if (MK_DUP == 31) { GRID_BAR(); attn_group<192, false, QW, KVW, KVW>(F, (char*)lds, (const bf16_t*)(ws + WS_QB), 192, (const bf16_t*)(ws + WS_K8), KV + 128, 256, (const bf16_t*)(ws + WS_KR8), nullptr, O, 0); }
        if (MK_DUP == 32) { GRID_BAR(); attn_group<128, true, PW, PW, PW>(F, (char*)lds, PROJ + 1024, 128, PROJ + 2048, PROJ + 3072, 128, nullptr, (const float*)(ws + WS_CUM), O + 1024, 8); }
        if (BOTH(3)) GRID_BAR();
    }
    STAMP(4);
    { int t_ = threadIdx.x; asm volatile("" : "+v"(t_)); F.tid = t_; F.lane = t_ & 63; }
    STAMP(5);
    if (IN(5)) {
        pg8::DenseSched S; S.o.init(T / 256, DM / 256, F.G, (int)blockIdx.x); S.A = FP8O ? ws + WS_HN : ws + WS_O; S.Bt = ws + WS_WO; S.lda = DM * (FP8O ? 1 : 2); S.ldb = S.lda;
        EpiWo E{args.in[0], args.out, ws + WS_XB, (const float*)(ws + WS_RR)};
        { pg8::Unit u0;
          for (int i = 0; i < 64; i += 2) { const int ii = i + (F.tid >> 8); if (!S.next(i, u0)) break; pg8::Unit u1; if (S.next(ii, u1)) onorm_tile(F, u1.pm, F.tid & 255); }
          asm volatile("s_waitcnt vmcnt(0)" ::: "memory"); __syncthreads(); }
        pg8::gemm_phase<EpiWo, pg8::DenseSched, false, FP8O>(F.lds, S.lda, S, E);
        if (MK_DUP == 5) { GRID_BAR(); pg8::gemm_phase<EpiWo, pg8::DenseSched, false, FP8O>(F.lds, S.lda, S, E); }
        if (BOTH(5)) GRID_BAR();
    }
    STAMP(6);
    if (IN(6)) { p6_router(F, args); if (BOTH(6)) GRID_BAR(); }
    STAMP(7);
    if (IN(7)) {
        moe_tables(F);
        pg8::MoeSched S; S.o.init(tstart[NE], 16, F.G, (int)blockIdx.x); S.A = ws + WS_XB; S.Bt = ws + WS_WGU; S.lda = DM * (USE_FP8 ? 1 : 2); S.ldb = S.lda; S.nBrows = 4096;
        S.tstart = tstart; S.list = (const int*)(ws + WS_LIST); S.cnt = F.ctl + CW_CNT; S.gather = true;
        EpiGU E{ws + WS_H, args.in[15], (const float*)(ws + WS_LISTR), tstart};
        pg8::gemm_phase<EpiGU, pg8::MoeSched, true, USE_FP8>(F.lds, S.lda, S, E);
        if (MK_DUP == 7) { GRID_BAR(); pg8::gemm_phase<EpiGU, pg8::MoeSched, true, USE_FP8>(F.lds, S.lda, S, E); }
        if (BOTH(7)) GRID_BAR();
    }
    STAMP(8);
    if (IN(8)) {
        moe_tables(F);
        pg8::MoeSched S; S.o.init(tstart[NE], 8, F.G, (int)blockIdx.x); S.A = ws + WS_H; S.Bt = ws + WS_WDN; S.lda = DM * (USE_FP8 ? 1 : 2); S.ldb = S.lda; S.nBrows = DM;
        S.tstart = tstart; S.list = (const int*)(ws + WS_LIST); S.cnt = F.ctl + CW_CNT; S.gather = false;
        EpiDn E{ws + WS_YK, args.in[17]};
        pg8::gemm_phase<EpiDn, pg8::MoeSched, false, USE_FP8>(F.lds, S.lda, S, E);
        if (MK_DUP == 8) { GRID_BAR(); pg8::gemm_phase<EpiDn, pg8::MoeSched, false, USE_FP8>(F.lds, S.lda, S, E); }
        if (BOTH(8)) GRID_BAR();
    }
    STAMP(9);
#ifdef MK_TPROBE
    GRID_BAR();
#endif
    if (IN(9)) { moe_tables(F); p9_final(F, args); }
    if (IN(20)) dbg_final_norm(F, args, args.in[0]);
    if (IN(21)) dbg_final_norm(F, args, args.out);
#undef IN
#undef BOTH
}

extern "C" void kernel_launch(void* const* d_in, const int* in_sizes, int n_in, void* d_out, int out_size, void* d_ws, size_t ws_size, hipStream_t stream) {
    static int grid = 0;
    if (grid == 0) {
        if (n_in != 19 || in_sizes[0] != T * DM || out_size != T * DM || ws_size < WS_END) {
            fprintf(stderr, "kernel_launch: unexpected shapes (n_in %d, in0 %d, out %d, ws %zu < %zu); nothing launched\n", n_in, n_in > 0 ? in_sizes[0] : -1, out_size, ws_size, (size_t)WS_END); grid = -1; return; }
        int dev = 0, cus = 0, per_cu = 0;
        if (hipGetDevice(&dev) != hipSuccess || hipDeviceGetAttribute(&cus, hipDeviceAttributeMultiprocessorCount, dev) != hipSuccess) { grid = -1; return; }
        if (hipFuncSetAttribute((const void*)mk_fwd, hipFuncAttributeMaxDynamicSharedMemorySize, LDS_BYTES) != hipSuccess) { fprintf(stderr, "kernel_launch: hipFuncSetAttribute failed\n"); grid = -1; return; }
        if (hipOccupancyMaxActiveBlocksPerMultiprocessor(&per_cu, (const void*)mk_fwd, NWAVES * 64, LDS_BYTES) != hipSuccess || per_cu < 1)
            fprintf(stderr, "kernel_launch: note: occupancy query reports %d workgroups per CU\n", per_cu);
        (void)hipGetLastError();
        grid = cus;
    }
    if (grid < 0) return;
    if (hipMemsetAsync((char*)d_ws + WS_CTL, 0, CTL_ZERO_BYTES, stream) != hipSuccess) return;
    Args a{};
    for (int i = 0; i < 19; ++i) a.in[i] = (const float*)d_in[i];
    a.out = (float*)d_out; a.ws = (unsigned char*)d_ws;
#if MK_ONE_LAUNCH
    a.ph_lo = 0; a.ph_hi = MK_PH_END;
    hipLaunchKernelGGL(mk_fwd, dim3(grid), dim3(NWAVES * 64), LDS_BYTES, stream, a);
#else
    for (int p = 0; p < MK_PH_END; ++p) { a.ph_lo = p; a.ph_hi = p + 1; hipLaunchKernelGGL(mk_fwd, dim3(grid), dim3(NWAVES * 64), LDS_BYTES, stream, a); }
#endif
#ifdef MK_DBG_PHASE
    a.ph_lo = MK_DBG_PHASE; a.ph_hi = MK_DBG_PHASE + 1; hipLaunchKernelGGL(mk_fwd, dim3(grid), dim3(NWAVES * 64), LDS_BYTES, stream, a);
#endif
}
```

```cpp
#include <hip/hip_runtime.h>
#include <cstdio>
#include <cstdint>

#ifndef MK_FP8
#define MK_FP8 1
#endif
constexpr bool USE_FP8 = MK_FP8;
#ifndef MK_FP8D
#define MK_FP8D 0
#endif
constexpr bool FP8D = MK_FP8D;
#ifndef MK_FP8O
#define MK_FP8O 0
#endif
constexpr bool FP8O = MK_FP8O;
#ifndef MK_DUP
#define MK_DUP -1
#endif
#ifndef MK_ONE_LAUNCH
#define MK_ONE_LAUNCH 1
#endif
#ifndef MK_PH_END
#define MK_PH_END 10
#endif

#define LAS __attribute__((address_space(3)))
#define GAS __attribute__((address_space(1)))
typedef unsigned short bf16_t;
typedef short bf16x8 __attribute__((ext_vector_type(8)));
typedef short s16x4 __attribute__((ext_vector_type(4)));
typedef float f32x2 __attribute__((ext_vector_type(2)));
typedef float f32x4 __attribute__((ext_vector_type(4)));
typedef float f32x16 __attribute__((ext_vector_type(16)));
typedef unsigned u32x2 __attribute__((ext_vector_type(2)));
typedef unsigned u32x4 __attribute__((ext_vector_type(4)));
typedef int i32x2 __attribute__((ext_vector_type(2)));
typedef int i32x4 __attribute__((ext_vector_type(4)));
typedef int i32x8 __attribute__((ext_vector_type(8)));

constexpr int NB = 4, SEQ = 8192, T = NB * SEQ, DM = 2048;
constexpr int NIN = 4168;
constexpr int PW = 4096;
constexpr int NE = 32, TOPK = 4;
constexpr int QW = 1536, KVW = 2048;
constexpr float EPS = 1e-5f;
constexpr int LIST_CAP = T;
constexpr int MAX_RT = 544;

constexpr size_t MiB = 1u << 20;
constexpr size_t WS_CTL = 0, CTL_ZERO_BYTES = 2 * MiB;
constexpr size_t WS_SSQ = 2772 * MiB;
constexpr size_t WS_ROPE = 2 * MiB;
constexpr size_t WS_WR = 4 * MiB;
constexpr size_t WS_FL = 5 * MiB;
constexpr size_t WS_CUM = 6 * MiB;
constexpr size_t WS_KR = 7 * MiB;
constexpr size_t WS_RE = 11 * MiB, WS_RP = WS_RE + 512 * 1024, WS_RG = WS_RP + 512 * 1024;
constexpr size_t WS_LIST = 13 * MiB;
constexpr size_t WS_LISTR = 17 * MiB;
constexpr size_t WS_WIN = 22 * MiB;
constexpr size_t WS_WQB = 39 * MiB;
constexpr size_t WS_WKVB = 41 * MiB;
constexpr size_t WS_WO = 43 * MiB;
constexpr size_t WS_WGU = 52 * MiB;
constexpr size_t WS_WDN = 564 * MiB;
constexpr size_t WS_HN = 820 * MiB;
constexpr size_t WS_PROJ = 948 * MiB;
constexpr size_t WS_QB = 1204 * MiB;
constexpr size_t WS_KV = 1300 * MiB;
constexpr size_t WS_O = 1428 * MiB;
constexpr size_t WS_XB = 1556 * MiB;
constexpr size_t WS_H = 1684 * MiB;
constexpr size_t WS_YK = 2228 * MiB;
constexpr size_t WS_SS = 2774 * MiB;
constexpr size_t WS_RR = 2776 * MiB;
constexpr size_t WS_K8 = 2777 * MiB;
constexpr size_t WS_KR8 = 2809 * MiB;
constexpr size_t WS_NRMP = 2811 * MiB;
constexpr size_t WS_END = 2819 * MiB;
constexpr int CW_TMO = 0, CW_CODE = 1;
constexpr int CW_BAR = 4096;
constexpr int CW_NRM = 12288;
constexpr int CW_CNT = 16384;

constexpr int RING_BYTES = 147456;
constexpr int LDSCTL_OFF = RING_BYTES, MISC_OFF = LDSCTL_OFF + 320;
constexpr int TAB_OFF = LDSCTL_OFF + 1024;
constexpr int LDS_BYTES = 151552;
constexpr int UTAB_OFF = LDSCTL_OFF + 2048;
constexpr int NWAVES = 8;

#define RLX_AGENT __ATOMIC_RELAXED, __HIP_MEMORY_SCOPE_AGENT
#define LDS_WAIT() asm volatile("s_waitcnt lgkmcnt(0)" ::: "memory")
#define VM_WAIT() asm volatile("s_waitcnt vmcnt(0)" ::: "memory")
typedef GAS unsigned gu32;

__device__ __forceinline__ unsigned f2bf(float f) { unsigned u = __builtin_bit_cast(unsigned, f); return (u + 0x7fffu + ((u >> 16) & 1u)) >> 16; }
__device__ __forceinline__ unsigned pk2(float lo, float hi) { return f2bf(lo) | (f2bf(hi) << 16); }
__device__ __forceinline__ unsigned cvt_pk_bf16(float lo, float hi) { unsigned r; asm volatile("v_cvt_pk_bf16_f32 %0, %1, %2" : "=v"(r) : "v"(lo), "v"(hi)); return r; }
__device__ __forceinline__ u32x2 pack8f8(f32x4 a, f32x4 b) {
    unsigned lo = 0u, hi = 0u; lo = __builtin_amdgcn_cvt_pk_fp8_f32(a[0], a[1], lo, false); lo = __builtin_amdgcn_cvt_pk_fp8_f32(a[2], a[3], lo, true);
    hi = __builtin_amdgcn_cvt_pk_fp8_f32(b[0], b[1], hi, false); hi = __builtin_amdgcn_cvt_pk_fp8_f32(b[2], b[3], hi, true); return (u32x2){lo, hi}; }
__device__ __forceinline__ float bf_lo(unsigned w) { return __builtin_bit_cast(float, w << 16); }
__device__ __forceinline__ float bf_hi(unsigned w) { return __builtin_bit_cast(float, w & 0xffff0000u); }
__device__ __forceinline__ float wave_sum(float v) {
#pragma unroll
    for (int o = 1; o < 64; o <<= 1) v += __shfl_xor(v, o);
    return v;
}

#define XB_TMO      128
#define XB_XCNT(j)  (256  + 64 * (j))
#define XB_XSUB(j)  (1280 + 64 * (j))
#define XB_XGEN(j)  (2304 + 64 * (j))
#define XB_TOP      3328
#define XB_TOPGEN   3392
#define XCD_BAR_WORDS 3456
#define XB_SPIN_CAP (1u << 18)

__device__ __forceinline__ unsigned xb_ld(unsigned* p)              { return __hip_atomic_load(p, __ATOMIC_RELAXED, __HIP_MEMORY_SCOPE_AGENT); }
__device__ __forceinline__ unsigned xb_add(unsigned* p, unsigned v) { return __hip_atomic_fetch_add(p, v, __ATOMIC_RELAXED, __HIP_MEMORY_SCOPE_AGENT); }
__device__ __forceinline__ unsigned xb_xcc_id() { return (unsigned)__builtin_amdgcn_s_getreg((3 << 11) | 20) & 0xFu; }
#define XB_SPIN(cond, bar) do { unsigned _sp = 0; while (cond) { __builtin_amdgcn_s_sleep(1); \
    if ((++_sp & 255u) == 0u) { if (xb_ld(&(bar)[XB_TMO])) break; if (_sp > XB_SPIN_CAP) { atomicAdd(&(bar)[XB_TMO], 1u); break; } } } } while (0)

struct XcdBarrier { unsigned* bar; unsigned x; volatile LAS unsigned* st; };

__device__ __forceinline__ XcdBarrier xcd_barrier_post(unsigned* bar, volatile LAS unsigned* st) {
    XcdBarrier b; b.bar = bar; b.x = xb_xcc_id(); b.st = st;
    if (threadIdx.x == 0) (void)xb_add(&bar[XB_XCNT(b.x)], 1u);
    return b;
}
__device__ __forceinline__ void xcd_barrier_complete(unsigned* bar, unsigned x, unsigned& nloc, unsigned& nx) {
    const unsigned G = gridDim.x * gridDim.y * gridDim.z;
    unsigned sum, cnt, mine, sp = 0u;
    for (;;) {
        sum = 0u; cnt = 0u; mine = 0u;
#pragma unroll
        for (unsigned j = 0; j < 16; ++j) { const unsigned c = xb_ld(&bar[XB_XCNT(j)]); sum += c; cnt += (c > 0u) ? 1u : 0u; mine = (j == x) ? c : mine; }
        if (sum == G) break;
        __builtin_amdgcn_s_sleep(1);
        if ((++sp & 255u) == 0u) { if (xb_ld(&bar[XB_TMO])) break; if (sp > XB_SPIN_CAP) { atomicAdd(&bar[XB_TMO], 1u); break; } }
    }
    nloc = mine > 0u ? mine : 1u; nx = cnt > 0u ? cnt : 1u;
}
__device__ __forceinline__ void xcd_barrier(const XcdBarrier& b) {
    asm volatile("s_waitcnt vmcnt(0)" ::: "memory");
    __syncthreads();
    if (threadIdx.x == 0) {
        unsigned* bar = b.bar;
        __builtin_amdgcn_s_waitcnt(0);
        unsigned nloc = b.st[0], nx = b.st[1];
        if (nloc == 0u) { xcd_barrier_complete(bar, b.x, nloc, nx); b.st[0] = nloc; b.st[1] = nx; }
        const unsigned old = xb_add(&bar[XB_XSUB(b.x)], 1u);
        const unsigned gen = old / nloc;
        if (old + 1u == (gen + 1u) * nloc) {
            __builtin_amdgcn_fence(__ATOMIC_RELEASE, "agent");
            asm volatile("s_waitcnt vmcnt(0)" ::: "memory");
            const unsigned og = xb_add(&bar[XB_TOP], 1u);
            const unsigned tg = og / nx;
            if (og + 1u == (tg + 1u) * nx) xb_add(&bar[XB_TOPGEN], 1u);
            else XB_SPIN(xb_ld(&bar[XB_TOPGEN]) == tg, bar);
            __builtin_amdgcn_fence(__ATOMIC_ACQUIRE, "agent");
            xb_add(&bar[XB_XGEN(b.x)], 1u);
            asm volatile("s_waitcnt vmcnt(0)" ::: "memory");
        } else {
            XB_SPIN(xb_ld(&bar[XB_XGEN(b.x)]) == gen, bar);
            __builtin_amdgcn_fence(__ATOMIC_ACQUIRE, "agent");
            asm volatile("s_waitcnt vmcnt(0)" ::: "memory");
        }
    }
    __syncthreads();
}

namespace pg8 {
constexpr int BM = 256, BK = 64, HALF = 128, HTB = HALF * BK * 2, STAGE_BYTES = 8 * HTB, NXCD = 8, WGM = 8;
__host__ __device__ __forceinline__ int lds_byte(int r, int c) { const int st = (r >> 4) * 2 + (c >> 5), rr = r & 15, cc = c & 31, ob = rr * 64 + cc * 2; return st * 1024 + (ob ^ (((ob >> 9) & 1) << 5)); }
__host__ __device__ __forceinline__ void stage_rc(int b, int& R, int& C) { const int st = b / 1024, sb = b % 1024, swz = sb ^ (((sb >> 9) & 1) << 5); R = (st >> 1) * 16 + swz / 64; C = (st & 1) * 32 + (swz % 64) / 2; }
__host__ __device__ __forceinline__ int perm32(int rho) { const int n = rho >> 4, i = rho & 15; return 8 * (i >> 2) + 4 * n + (i & 3); }

__device__ __forceinline__ const char* uni(const char* p) {
    const unsigned long long v = (unsigned long long)p; const unsigned lo = __builtin_amdgcn_readfirstlane((unsigned)v), hi = __builtin_amdgcn_readfirstlane((unsigned)(v >> 32));
    return (const char*)(((unsigned long long)hi << 32) | lo); }
__device__ __forceinline__ void ald(unsigned& v, const void* base, unsigned off) {
#ifdef MK_NOASMLD
    v = *(const unsigned*)((const char*)base + off);
#else
    asm volatile("s_nop 4\n\tglobal_load_dword %0, %1, %2" : "+v"(v) : "v"(off), "s"(base) : "memory");
#endif
}
struct Unit { int pm, pn, e; };

struct GridOrder {
    int nM, nN, nwg, G, c;
    __device__ __forceinline__ void init(int nM_, int nN_, int G_, int c_) { nM = __builtin_amdgcn_readfirstlane(nM_); nN = nN_; nwg = nM * nN; G = G_; c = __builtin_amdgcn_readfirstlane(c_); }
    __device__ __forceinline__ bool tile(int i, int& pm, int& pn) const {
        const int L = i * G + c; if (L >= nwg) return false;
        int wgid = L; { const int q = nwg / NXCD, r = nwg % NXCD, xcd = wgid % NXCD, off = wgid / NXCD; wgid = (xcd < r ? xcd * (q + 1) : r * (q + 1) + (xcd - r) * q) + off; }
        const int nig = WGM * nN, gid = wgid / nig, fm = gid * WGM, gsz = (nM - fm) < WGM ? (nM - fm) : WGM;
        pm = fm + ((wgid % nig) % gsz); pn = (wgid % nig) / gsz; return true;
    }
};
struct DenseSched {
    GridOrder o; const void* A; const void* Bt; int lda, ldb;
    __device__ __forceinline__ bool next(int i, Unit& u) const { u.e = 0; return o.tile(i, u.pm, u.pn); }
    __device__ __forceinline__ const char* a_ptr(const Unit& u) const { return (const char*)A + (size_t)u.pm * BM * lda; }
    __device__ __forceinline__ const char* b_ptr(const Unit& u) const { return (const char*)Bt + (size_t)u.pn * BM * ldb; }
    __device__ __forceinline__ unsigned a_off(const Unit&, int) const { return 0u; }
    __device__ __forceinline__ void a_raw(unsigned&, const Unit&, int) const {}
    __device__ __forceinline__ unsigned a_fix(const Unit&, int, int) const { return 0u; }
};
struct MoeSched {
    GridOrder o; const void* A; const void* Bt; int lda, ldb, nBrows; const LAS int* tstart;
    const int* list; const gu32* cnt; bool gather;
    __device__ __forceinline__ bool next(int i, Unit& u) const {
        if (!o.tile(i, u.pm, u.pn)) return false;
        int lo = 0;
#pragma unroll
        for (int s = 16; s >= 1; s >>= 1) { if (tstart[lo + s] <= u.pm) lo += s; }
        u.e = lo; return true;
    }
    __device__ __forceinline__ const char* a_ptr(const Unit& u) const { return gather ? (const char*)A : (const char*)A + (size_t)u.pm * BM * lda; }
    __device__ __forceinline__ const char* b_ptr(const Unit& u) const { return (const char*)Bt + ((size_t)u.e * nBrows + (size_t)u.pn * BM) * ldb; }
    __device__ __forceinline__ void a_raw(unsigned& dst, const Unit& u, int r) const { ald(dst, uni((const char*)list), (unsigned)(u.e * LIST_CAP + (u.pm - tstart[u.e]) * BM + r) * 4u); }
    __device__ __forceinline__ unsigned a_fix(const Unit& u, int r, int raw) const { const int rr = (u.pm - tstart[u.e]) * BM + r; return (unsigned)(rr < tstart[40 + u.e] ? raw : 0) * (unsigned)lda; }
    __device__ __forceinline__ unsigned a_off(const Unit& u, int r) const { unsigned raw = 0u; a_raw(raw, u, r); asm volatile("s_waitcnt vmcnt(0)" : "+v"(raw) :: "memory"); return a_fix(u, r, (int)raw); }
};

template <class Epi, class Sched, bool GATHER, bool FP8 = false>
__device__ __forceinline__ void gemm_phase(LAS unsigned char* lds, const int Kb, const Sched& S, const Epi& E) {
    int tid_ = threadIdx.x; asm volatile("" : "+v"(tid_));
    const int tid = tid_, wid = __builtin_amdgcn_readfirstlane(tid >> 6), lane = tid & 63, wr = wid >> 2, wc = wid & 3, fr = lane & 15, fq = lane >> 4;
    const int nt = Kb / (BK * 2);
    const int lda = S.lda, ldb = S.ldb;
    unsigned voffA[2], voffB[2]; int rowA[2];
#pragma unroll
    for (int i = 0; i < 2; ++i) { int R, C; stage_rc(tid * 16 + i * 8192, R, C); const int Rb = Epi::PERM ? ((R & ~31) + perm32(R & 31)) : R;
        rowA[i] = R; voffA[i] = GATHER ? (unsigned)(C * 2) : (unsigned)(R * lda + C * 2); voffB[i] = (unsigned)(Rb * ldb + C * 2); }
    const size_t kstep = (size_t)(BK * 2);
    const size_t hstepA = GATHER ? 0 : (size_t)HALF * lda, hstepB = (size_t)HALF * ldb;
    const unsigned ldsw = (unsigned)wid * 1024u, lds0 = (unsigned)(uintptr_t)lds;
    const int aoff = lds_byte(wr * 64 + fr, fq * 8), boff = lds_byte(wc * 32 + fr, fq * 8);
#define PG8_SA(b, h) (((b) * 2 + (h)) * HTB)
#define PG8_SB(b, h) ((4 + (b) * 2 + (h)) * HTB)
#define PG8_STAGE(bufoff, gbase, voff) do { _Pragma("unroll") for (int _i = 0; _i < 2; ++_i) { \
        if constexpr (GATHER) asm volatile("s_mov_b32 m0, %2\n\ts_nop 4\n\tglobal_load_lds_dwordx4 %0, %1" :: "v"((voff)[_i]), "s"((const char*)(gbase)), "s"(lds0 + (unsigned)(bufoff) + ldsw + (unsigned)(_i * 8192)) : "memory", "m0"); \
        else __builtin_amdgcn_global_load_lds((const unsigned*)((const char*)(gbase) + (voff)[_i]), (LAS unsigned*)(lds + (bufoff) + ldsw + _i * 8192), 16, 0, 0); } } while (0)
#define PG8_LD16(p) (*(const LAS i32x4*)(p))
#define PG8_LDA(dst, b, h) do { _Pragma("unroll") for (int m = 0; m < 4; ++m) { const LAS unsigned char* p_ = lds + PG8_SA(b, h) + aoff + m * 2048; \
        if constexpr (FP8) dst##8[m] = __builtin_shufflevector(PG8_LD16(p_), PG8_LD16(p_ + 1024), 0, 1, 2, 3, 4, 5, 6, 7); \
        else { dst[m][0] = *(const LAS bf16x8*)p_; dst[m][1] = *(const LAS bf16x8*)(p_ + 1024); } } } while (0)
#define PG8_LDB(dst, b, h) do { _Pragma("unroll") for (int n = 0; n < 2; ++n) { const LAS unsigned char* p_ = lds + PG8_SB(b, h) + boff + n * 2048; \
        if constexpr (FP8) dst##8[n] = __builtin_shufflevector(PG8_LD16(p_), PG8_LD16(p_ + 1024), 0, 1, 2, 3, 4, 5, 6, 7); \
        else { dst[n][0] = *(const LAS bf16x8*)p_; dst[n][1] = *(const LAS bf16x8*)(p_ + 1024); } } } while (0)
#define PG8_MMA(ai, bj, At, Bt) do { __builtin_amdgcn_s_setprio(1); _Pragma("unroll") for (int m = 0; m < 4; ++m) _Pragma("unroll") for (int n = 0; n < 2; ++n) { \
        if constexpr (FP8) asm volatile("v_mfma_f32_16x16x128_f8f6f4 %0, %1, %2, %0" : "+v"(acc[ai][bj][m][n]) : "v"(Bt##8[n]), "v"(At##8[m]));   \
        else { _Pragma("unroll") for (int k = 0; k < 2; ++k) acc[ai][bj][m][n] = __builtin_amdgcn_mfma_f32_16x16x32_bf16(Bt[n][k], At[m][k], acc[ai][bj][m][n], 0, 0, 0); } } \
        __builtin_amdgcn_s_setprio(0); } while (0)
#define PG8_WAIT_V(n) asm volatile("s_waitcnt vmcnt(" #n ")" ::: "memory")
#define PG8_WAIT_L(n) asm volatile("s_waitcnt lgkmcnt(" #n ")" ::: "memory")
#define PG8_BAR __builtin_amdgcn_s_barrier()
#define PG8_SCHED __builtin_amdgcn_sched_barrier(0)
    unsigned utab_off = UTAB_OFF; asm volatile("" : "+s"(utab_off));
    LAS int* utab = (LAS int*)(lds + utab_off);
    if (tid < 64) { Unit t; utab[tid] = S.next(tid, t) ? (t.pm | (t.pn << 12) | (t.e << 20)) : -1; }
    __syncthreads();
    auto unit_at = [&](int i, Unit& u) -> bool { const int v = __builtin_amdgcn_readfirstlane(i < 64 ? utab[i] : -1); if (v < 0) return false; u.pm = v & 0xfff; u.pn = (v >> 12) & 0xff; u.e = v >> 20; return true; };
    Unit cur, nxt; int ui = 0;
    if (!unit_at(0, cur)) return;
    f32x4 acc[2][2][4][2];
#pragma unroll
    for (int a = 0; a < 2; ++a)
#pragma unroll
        for (int b = 0; b < 2; ++b)
#pragma unroll
            for (int m = 0; m < 4; ++m)
#pragma unroll
                for (int n = 0; n < 2; ++n) acc[a][b][m][n] = (f32x4){0.f, 0.f, 0.f, 0.f};
    bf16x8 At[4][2], B0[2][2], B1[2][2];
    i32x8 At8[4], B08[2], B18[2];
    const char* cA = uni(S.a_ptr(cur)); const char* cB = uni(S.b_ptr(cur));
    unsigned c0[2] = {voffA[0], voffA[1]}, c1[2] = {voffA[0], voffA[1]};
    LAS float* sidetab = (LAS float*)(lds + STAGE_BYTES + 8192);
    LAS u32x4* nslot = (LAS u32x4*)(lds + STAGE_BYTES) + tid;
    if constexpr (GATHER) {
#pragma unroll
        for (int i = 0; i < 2; ++i) { c0[i] = 0u; c1[i] = 0u; S.a_raw(c0[i], cur, rowA[i]); S.a_raw(c1[i], cur, HALF + rowA[i]); }
        asm volatile("s_waitcnt vmcnt(0)" : "+v"(c0[0]), "+v"(c0[1]), "+v"(c1[0]), "+v"(c1[1]) :: "memory");
#pragma unroll
        for (int i = 0; i < 2; ++i) { c0[i] = voffA[i] + S.a_fix(cur, rowA[i], (int)c0[i]); c1[i] = voffA[i] + S.a_fix(cur, HALF + rowA[i], (int)c1[i]); }
    }
#define PG8_STAGE_A(bufoff, kptr, h, o0, o1) do { if constexpr (GATHER) { if ((h) == 0) PG8_STAGE(bufoff, kptr, o0); else PG8_STAGE(bufoff, kptr, o1); } \
        else { PG8_STAGE(bufoff, (kptr) + (h) * hstepA, voffA); } } while (0)
    PG8_STAGE(PG8_SB(0, 0), cB, voffB); PG8_STAGE(PG8_SB(0, 1), cB + hstepB, voffB); PG8_STAGE_A(PG8_SA(0, 0), cA, 0, c0, c1); PG8_STAGE_A(PG8_SA(0, 1), cA, 1, c0, c1);
    if (wr == 1) PG8_BAR;
    PG8_WAIT_V(2); PG8_BAR;
    PG8_STAGE(PG8_SB(1, 0), cB + kstep, voffB); PG8_STAGE_A(PG8_SA(1, 0), cA + kstep, 0, c0, c1); PG8_STAGE(PG8_SB(1, 1), cB + hstepB + kstep, voffB);
    PG8_WAIT_V(6); PG8_BAR;
    bool has_next = unit_at(1, nxt);
    if constexpr (Epi::SIDE) { unsigned s0[2] = {0u, 0u}, s1[2] = {0u, 0u}; E.side_load(s0, cur, tid & 255); E.side_load(s1, has_next ? nxt : cur, tid & 255);
        asm volatile("s_waitcnt vmcnt(0)" : "+v"(s0[0]), "+v"(s0[1]), "+v"(s1[0]), "+v"(s1[1]) :: "memory");
        if (tid < 256) { sidetab[tid] = __builtin_bit_cast(float, s0[0]); sidetab[512 + tid] = __builtin_bit_cast(float, s1[0]); if constexpr (Epi::SIDE2) { sidetab[256 + tid] = __builtin_bit_cast(float, s0[1]); sidetab[768 + tid] = __builtin_bit_cast(float, s1[1]); } } }
    if constexpr (GATHER) { u32x4 nv = {c0[0], c0[1], c1[0], c1[1]};
        if (has_next) { unsigned r0 = 0u, r1 = 0u, r2 = 0u, r3 = 0u; S.a_raw(r0, nxt, rowA[0]); S.a_raw(r1, nxt, rowA[1]); S.a_raw(r2, nxt, HALF + rowA[0]); S.a_raw(r3, nxt, HALF + rowA[1]);
            asm volatile("s_waitcnt vmcnt(0)" : "+v"(r0), "+v"(r1), "+v"(r2), "+v"(r3) :: "memory");
            nv = (u32x4){voffA[0] + S.a_fix(nxt, rowA[0], (int)r0), voffA[1] + S.a_fix(nxt, rowA[1], (int)r1), voffA[0] + S.a_fix(nxt, HALF + rowA[0], (int)r2), voffA[1] + S.a_fix(nxt, HALF + rowA[1], (int)r3)}; }
        *nslot = nv; }
    for (;;) {
        const char* nA = has_next ? uni(S.a_ptr(nxt)) : cA; const char* nB = has_next ? uni(S.b_ptr(nxt)) : cB;
        Unit nn; const bool has_nn = has_next && unit_at(ui + 2, nn);
        if (!has_nn) nn = cur;
        unsigned raw[4] = {0u, 0u, 0u, 0u}, sraw[2] = {0u, 0u};
        if constexpr (Epi::SIDE) E.side_load(sraw, nn, tid & 255);
        if constexpr (GATHER) { int t2 = threadIdx.x; asm volatile("" : "+v"(t2));
#pragma unroll
            for (int i = 0; i < 2; ++i) { int R, C; stage_rc(t2 * 16 + i * 8192, R, C); S.a_raw(raw[i], nn, R); S.a_raw(raw[2 + i], nn, HALF + R); } }
        constexpr int NLOOK = (Epi::SIDE ? (Epi::SIDE2 ? 2 : 1) : 0) + (GATHER ? 4 : 0);
#define PG8_KBODY(a1_, a2_, b2_, X0, X1) do { const char* a3_ = (a2_) + kstep; const char* b3_ = (b2_) + kstep; \
              \
            PG8_LDB(B0, 0, 0); PG8_LDB(B1, 0, 1); PG8_SCHED; PG8_LDA(At, 0, 0); PG8_STAGE_A(PG8_SA(1, 1), a1_, 1, c0, c1); \
            PG8_WAIT_V(8); PG8_WAIT_L(0); PG8_BAR; PG8_MMA(0, 0, At, B0); PG8_MMA(0, 1, At, B1); PG8_BAR; PG8_SCHED; \
              \
            PG8_LDA(At, 0, 1); PG8_STAGE(PG8_SB(0, 0), b2_, voffB); PG8_STAGE(PG8_SB(0, 1), (b2_) + hstepB, voffB); PG8_STAGE_A(PG8_SA(0, 0), a2_, 0, X0, X1); \
            PG8_WAIT_V(8); PG8_WAIT_L(0); PG8_BAR; PG8_MMA(1, 0, At, B0); PG8_MMA(1, 1, At, B1); PG8_BAR; PG8_SCHED; \
              \
            PG8_LDB(B0, 1, 0); PG8_LDB(B1, 1, 1); PG8_SCHED; PG8_LDA(At, 1, 0); PG8_STAGE_A(PG8_SA(0, 1), a2_, 1, X0, X1); \
            PG8_WAIT_V(8); PG8_WAIT_L(0); PG8_BAR; PG8_MMA(0, 0, At, B0); PG8_MMA(0, 1, At, B1); PG8_BAR; PG8_SCHED; \
              \
            PG8_LDA(At, 1, 1); PG8_STAGE(PG8_SB(1, 0), b3_, voffB); PG8_STAGE(PG8_SB(1, 1), b3_ + hstepB, voffB); PG8_STAGE_A(PG8_SA(1, 0), a3_, 0, X0, X1); \
            PG8_WAIT_V(8); PG8_WAIT_L(0); PG8_BAR; PG8_MMA(1, 0, At, B0); PG8_MMA(1, 1, At, B1); PG8_BAR; PG8_SCHED; } while (0)
#define PG8_WAIT_VI(n) asm volatile("s_waitcnt vmcnt(%0)" :: "i"(n) : "memory")
#define PG8_KBODY_FIRST(a2_, b2_, NS) do { const char* a3_ = (a2_) + kstep; const char* b3_ = (b2_) + kstep; \
            PG8_LDB(B0, 0, 0); PG8_LDB(B1, 0, 1); PG8_SCHED; PG8_LDA(At, 0, 0); \
            PG8_WAIT_VI(8 + NS); PG8_WAIT_L(0); PG8_BAR; PG8_MMA(0, 0, At, B0); PG8_MMA(0, 1, At, B1); PG8_BAR; PG8_SCHED; \
            PG8_LDA(At, 0, 1); PG8_STAGE(PG8_SB(0, 0), b2_, voffB); PG8_STAGE(PG8_SB(0, 1), (b2_) + hstepB, voffB); PG8_STAGE_A(PG8_SA(0, 0), a2_, 0, c0, c1); \
            PG8_WAIT_VI(8 + NS); PG8_WAIT_L(0); PG8_BAR; PG8_MMA(1, 0, At, B0); PG8_MMA(1, 1, At, B1); PG8_BAR; PG8_SCHED; \
            PG8_LDB(B0, 1, 0); PG8_LDB(B1, 1, 1); PG8_SCHED; PG8_LDA(At, 1, 0); PG8_STAGE_A(PG8_SA(0, 1), a2_, 1, c0, c1); \
            PG8_WAIT_VI(8 + NS); PG8_WAIT_L(0); PG8_BAR; PG8_MMA(0, 0, At, B0); PG8_MMA(0, 1, At, B1); PG8_BAR; PG8_SCHED; \
            PG8_LDA(At, 1, 1); PG8_STAGE(PG8_SB(1, 0), b3_, voffB); PG8_STAGE(PG8_SB(1, 1), b3_ + hstepB, voffB); PG8_STAGE_A(PG8_SA(1, 0), a3_, 0, c0, c1); \
            PG8_WAIT_V(8); PG8_WAIT_L(0); PG8_BAR; PG8_MMA(1, 0, At, B0); PG8_MMA(1, 1, At, B1); PG8_BAR; PG8_SCHED; } while (0)
        constexpr bool RELAX = (MK_DUP != 101) && Epi::NSTORE > 0;
        if constexpr (GATHER) {
            int t0 = 0;
            if constexpr (RELAX) { if (ui > 0) { PG8_KBODY_FIRST(cA + 2 * kstep, cB + 2 * kstep, Epi::NSTORE + NLOOK); t0 = 2; } }
            for (int t = t0; t < nt - 2; t += 2) { const char* a1 = cA + (size_t)(t + 1) * kstep; const char* a2 = cA + (size_t)(t + 2) * kstep; const char* b2 = cB + (size_t)(t + 2) * kstep; PG8_KBODY(a1, a2, b2, c0, c1); }
            { const u32x4 nv = *nslot; const unsigned n0[2] = {nv[0], nv[1]}, n1[2] = {nv[2], nv[3]}; const char* a1 = cA + (size_t)(nt - 1) * kstep; PG8_KBODY(a1, nA, nB, n0, n1);
              if constexpr (RELAX) { if (has_next) PG8_STAGE_A(PG8_SA(1, 1), nA + kstep, 1, n0, n1); } }
        } else {
            constexpr int REP = (MK_DUP == 101 && FP8) ? 2 : 1;
            int tt0 = 0;
            if constexpr (RELAX) { if (ui > 0) { PG8_KBODY_FIRST(cA + 2 * kstep, cB + 2 * kstep, Epi::NSTORE + NLOOK); tt0 = 2; } }
            for (int tt = tt0; tt < REP * nt; tt += 2) {
                const int t = REP == 1 ? tt : (tt >= nt ? tt - nt : tt);
                if constexpr (Epi::MIDK) { if (tt == nt / 2) E.midk(acc, wr, fr, sidetab + (ui % 3) * 512); }
                const bool last = (tt == REP * nt - 2), wrap = (t == nt - 2);
                const char* a1 = cA + (size_t)(t + 1) * kstep;
                const char* a2 = last ? nA : (wrap ? cA : cA + (size_t)(t + 2) * kstep); const char* b2 = last ? nB : (wrap ? cB : cB + (size_t)(t + 2) * kstep);
                PG8_KBODY(a1, a2, b2, c0, c1);
            }
            if constexpr (RELAX) { if (has_next) PG8_STAGE_A(PG8_SA(1, 1), nA + kstep, 1, c0, c1); }
        }
        if (wr == 0) PG8_BAR;
        if constexpr (FP8) asm volatile("s_nop 15\n\ts_nop 15" ::: "memory");
        { int t2 = threadIdx.x; asm volatile("" : "+v"(t2)); const int l2 = t2 & 63, w2 = t2 >> 6;
          if constexpr (Epi::SIDE) E(acc, cur, w2 >> 2, w2 & 3, l2 & 15, l2 >> 4, sidetab + (ui % 3) * 512); else E(acc, cur, w2 >> 2, w2 & 3, l2 & 15, l2 >> 4); }
        if (!has_next) break;
#pragma unroll
        for (int a = 0; a < 2; ++a)
#pragma unroll
            for (int b = 0; b < 2; ++b)
#pragma unroll
                for (int m = 0; m < 4; ++m)
#pragma unroll
                    for (int n = 0; n < 2; ++n) acc[a][b][m][n] = (f32x4){0.f, 0.f, 0.f, 0.f};
        cur = nxt; cA = nA; cB = nB; ++ui;
        asm volatile("" : "+v"(raw[0]), "+v"(raw[1]), "+v"(raw[2]), "+v"(raw[3]), "+v"(sraw[0]), "+v"(sraw[1]));
        if constexpr (GATHER) { const u32x4 nv = *nslot; c0[0] = nv[0]; c0[1] = nv[1]; c1[0] = nv[2]; c1[1] = nv[3];
            if (has_nn) { int t2 = threadIdx.x; asm volatile("" : "+v"(t2)); u32x4 nw;
#pragma unroll
                for (int i = 0; i < 2; ++i) { int R, C; stage_rc(t2 * 16 + i * 8192, R, C); const unsigned vo = (unsigned)(C * 2); nw[i] = vo + S.a_fix(nn, R, (int)raw[i]); nw[2 + i] = vo + S.a_fix(nn, HALF + R, (int)raw[2 + i]); }
                *nslot = nw; } }
        if constexpr (Epi::SIDE) { if (has_nn) { LAS float* t3 = sidetab + ((ui + 1) % 3) * 512; if (tid < 256) { t3[tid] = __builtin_bit_cast(float, sraw[0]); if constexpr (Epi::SIDE2) t3[256 + tid] = __builtin_bit_cast(float, sraw[1]); } } }
        nxt = nn; has_next = has_nn;
        if (wr == 1) PG8_BAR;
    }
    PG8_WAIT_V(0);
    PG8_BAR;
#undef PG8_SA
#undef PG8_SB
#undef PG8_STAGE
#undef PG8_STAGE_A
#undef PG8_KBODY
#undef PG8_KBODY_FIRST
#undef PG8_WAIT_VI
#undef PG8_LDA
#undef PG8_LDB
#undef PG8_MMA
#undef PG8_LD16
#undef PG8_WAIT_V
#undef PG8_WAIT_L
#undef PG8_BAR
#undef PG8_SCHED
}
}

namespace att {
constexpr int NW = 8, QBLK = 32, KVBLK = 64, QB = NW * QBLK;
constexpr int SHM_V = KVBLK * 128 * 2, KP = 272, SHM_K = KVBLK * KP, KRP = 144, SHM_KR = KVBLK * KRP, QLP = 208, SHM_QR = QBLK * QLP;
constexpr int OFF_V = 0, OFF_K = 2 * SHM_V, OFF_KR = OFF_K + 2 * SHM_K, OFF_WS = OFF_KR + 2 * SHM_KR, OFF_NC = OFF_WS + NW * 64 * 4, OFF_QR = OFF_NC + 2 * 256, LDS_BYTES = OFF_QR + NW * SHM_QR;
constexpr int LDO = 2048;
constexpr int K8P = 208, SHM_K8 = KVBLK * K8P;
#define KSWZ(row, colB) ((row) * KP + (colB))
#define KRSWZ(row, colB) ((row) * KRP + (colB))
#define SBAR() __builtin_amdgcn_sched_barrier(0)
__device__ __forceinline__ int v_st(int k, int c) { const int kk = (k & ~0xC) | ((k & 4) << 1) | ((k & 8) >> 1); return ((kk >> 3) * 4 + (c >> 5)) * 512 + ((kk & 7) * 32 + (c & 31)) * 2; }
__device__ __forceinline__ int v_rd_base(int lane) { return ((lane & 3) << 3) | (((lane >> 2) & 3) << 6) | (((lane >> 4) & 1) << 5) | (((lane >> 5) & 1) << 8); }
constexpr int v_rd_off(int d0, int ks, int half) { return d0 * 512 + ks * 4096 + half * 2048; }
__device__ __forceinline__ int crow(int r, int hi) { return (r & 3) + 8 * (r >> 2) + 4 * hi; }
__device__ __forceinline__ bf16x8 load8(const bf16_t* p) { return *reinterpret_cast<const bf16x8*>(p); }
__device__ __forceinline__ void mask_tile(f32x16& p0, f32x16& p1, int dq) {
    const float NEG = -__builtin_inff();
#pragma unroll
    for (int r = 0; r < 16; ++r) {
        const int c = (r & 3) + 8 * (r >> 2);
        if (dq - c < 0) p0[r] = NEG;
        if (dq - c - 32 < 0) p1[r] = NEG;
    }
}
template <int DK>
__device__ __forceinline__ void partialSM(f32x16& p0, f32x16& p1, float& m_reg, float& mn, float& alpha) {
    constexpr float SCALE = DK == 128 ? 0.08838834764831845f : 0.07216878364870323f, THR = 8.f;
    float pmax = p0[0];
#pragma unroll
    for (int r = 1; r < 16; ++r) pmax = fmaxf(pmax, p0[r]);
#pragma unroll
    for (int r = 0; r < 16; ++r) pmax = fmaxf(pmax, p1[r]);
    { auto rr = __builtin_amdgcn_permlane32_swap(__float_as_uint(pmax), __float_as_uint(pmax), false, false);
      pmax = fmaxf(__uint_as_float(rr[0]), __uint_as_float(rr[1])); }
    constexpr float C2 = 1.4426950408889634f * SCALE;
    if (__builtin_expect(__all((pmax - m_reg) * SCALE <= THR), 1)) { mn = m_reg; alpha = 1.f; }
    else { mn = fmaxf(m_reg, pmax); alpha = __builtin_amdgcn_exp2f((m_reg - mn) * C2); m_reg = mn; }
    const float mnL = -mn * C2;
#pragma unroll
    for (int r = 0; r < 16; ++r) p0[r] = fmaf(p0[r], C2, mnL);
#pragma unroll
    for (int r = 0; r < 16; ++r) p1[r] = fmaf(p1[r], C2, mnL);
#pragma unroll
    for (int r = 0; r < 16; ++r) p0[r] = __builtin_amdgcn_exp2f(p0[r]);
}
__device__ __forceinline__ void finishSM(f32x16& p0, f32x16& p1, float alpha, float& l_reg, bf16x8& pa0, bf16x8& pa1, bf16x8& pa2, bf16x8& pa3) {
#pragma unroll
    for (int r = 0; r < 16; ++r) p1[r] = __builtin_amdgcn_exp2f(p1[r]);
    float ps = 0;
#pragma unroll
    for (int r = 0; r < 16; ++r) ps += p0[r];
#pragma unroll
    for (int r = 0; r < 16; ++r) ps += p1[r];
    { auto rr = __builtin_amdgcn_permlane32_swap(__float_as_uint(ps), __float_as_uint(ps), false, false);
      ps = __uint_as_float(rr[0]) + __uint_as_float(rr[1]); }
    l_reg = l_reg * alpha + ps;
#define PK4(P, B_, OUT) do { unsigned a0 = cvt_pk_bf16(P[B_+0], P[B_+1]), a1 = cvt_pk_bf16(P[B_+2], P[B_+3]);                  \
        unsigned b0 = cvt_pk_bf16(P[B_+4], P[B_+5]), b1 = cvt_pk_bf16(P[B_+6], P[B_+7]);                                       \
        auto r0 = __builtin_amdgcn_permlane32_swap(a0, b0, false, false); auto r1 = __builtin_amdgcn_permlane32_swap(a1, b1, false, false); \
        u32x4 w = {r0[0], r1[0], r0[1], r1[1]}; OUT = *reinterpret_cast<bf16x8*>(&w); } while (0)
    PK4(p0, 0, pa0); PK4(p0, 8, pa1); PK4(p1, 0, pa2); PK4(p1, 8, pa3);
#undef PK4
}
template <int KB>
__device__ __forceinline__ void qkt8(f32x16& p0, f32x16& p1, const char* lds, int r32, int hi, const i32x8* q8) {
    p0 = f32x16{}; p1 = f32x16{};
    const char* kb = lds + OFF_K + KB * SHM_K8 + r32 * K8P + hi * 32;
#pragma unroll
    for (int s = 0; s < 3; ++s) {
        const i32x4 a0 = *reinterpret_cast<const i32x4*>(kb + 64 * s), a1 = *reinterpret_cast<const i32x4*>(kb + 64 * s + 16);
        const i32x4 b0 = *reinterpret_cast<const i32x4*>(kb + 64 * s + 32 * K8P), b1 = *reinterpret_cast<const i32x4*>(kb + 64 * s + 32 * K8P + 16);
        p0 = __builtin_amdgcn_mfma_scale_f32_32x32x64_f8f6f4(__builtin_shufflevector(a0, a1, 0, 1, 2, 3, 4, 5, 6, 7), q8[s], p0, 0, 0, 0, 0, 0, 0);
        p1 = __builtin_amdgcn_mfma_scale_f32_32x32x64_f8f6f4(__builtin_shufflevector(b0, b1, 0, 1, 2, 3, 4, 5, 6, 7), q8[s], p1, 0, 0, 0, 0, 0, 0); }
}
template <int KB, int DK, bool BIAS>
__device__ __forceinline__ void qkt(f32x16& p0, f32x16& p1, const char* lds, int r32, int hi, const bf16x8* qr) {
    if constexpr (BIAS) {
        const float* nc = (const float*)(lds + OFF_NC + KB * 256);
#pragma unroll
        for (int g = 0; g < 4; ++g) { const f32x4 a = *(const f32x4*)(nc + 8 * g + 4 * hi), b = *(const f32x4*)(nc + 32 + 8 * g + 4 * hi);
            p0[4 * g] = a[0]; p0[4 * g + 1] = a[1]; p0[4 * g + 2] = a[2]; p0[4 * g + 3] = a[3];
            p1[4 * g] = b[0]; p1[4 * g + 1] = b[1]; p1[4 * g + 2] = b[2]; p1[4 * g + 3] = b[3]; }
    } else { p0 = f32x16{}; p1 = f32x16{}; }
    const char* kb = lds + OFF_K + KB * SHM_K + r32 * KP + hi * 16;
#pragma unroll
    for (int d0 = 0; d0 < 8; ++d0) {
        bf16x8 b0 = *reinterpret_cast<const bf16x8*>(kb + d0 * 32);
        bf16x8 b1 = *reinterpret_cast<const bf16x8*>(kb + d0 * 32 + 32 * KP);
        p0 = __builtin_amdgcn_mfma_f32_32x32x16_bf16(b0, qr[d0], p0, 0, 0, 0);
        p1 = __builtin_amdgcn_mfma_f32_32x32x16_bf16(b1, qr[d0], p1, 0, 0, 0); }
}
template <int VB>
__device__ __forceinline__ void pv_tile(f32x16* o, int vb0, bf16x8 pa0, bf16x8 pa1, bf16x8 pa2, bf16x8 pa3) {
#define TRRD(dst, off) asm volatile("ds_read_b64_tr_b16 %0, %1 offset:%2" : "=&v"(dst) : "v"(vb0), "i"(off) : "memory")
#define PV_RD(d0, p, X0, X1, X2, X3) do { constexpr int b_ = VB * SHM_V + v_rd_off(d0, 0, 0) + (p) * 8192; TRRD(X0, b_); TRRD(X1, b_ + 2048); TRRD(X2, b_ + 4096); TRRD(X3, b_ + 6144); } while (0)
#define PV_MM(d0, PA, PB, X0, X1, X2, X3) do { \
        o[d0] = __builtin_amdgcn_mfma_f32_32x32x16_bf16(PA, (bf16x8){X0[0], X0[1], X0[2], X0[3], X1[0], X1[1], X1[2], X1[3]}, o[d0], 0, 0, 0); \
        o[d0] = __builtin_amdgcn_mfma_f32_32x32x16_bf16(PB, (bf16x8){X2[0], X2[1], X2[2], X2[3], X3[0], X3[1], X3[2], X3[3]}, o[d0], 0, 0, 0); } while (0)
#define PV_W4() do { asm volatile("s_waitcnt lgkmcnt(4)" ::: "memory"); SBAR(); } while (0)
#define PV_W0() do { asm volatile("s_waitcnt lgkmcnt(0)" ::: "memory"); SBAR(); } while (0)
#define PV_RH(q, X0, X1) do { constexpr int b_ = VB * SHM_V + v_rd_off((q) >> 2, 0, 0) + ((q) & 3) * 4096; TRRD(X0, b_); TRRD(X1, b_ + 2048); } while (0)
#define PV_M1(q, PA, X0, X1) o[(q) >> 2] = __builtin_amdgcn_mfma_f32_32x32x16_bf16(PA, (bf16x8){X0[0], X0[1], X0[2], X0[3], X1[0], X1[1], X1[2], X1[3]}, o[(q) >> 2], 0, 0, 0)
#define PV_WN(n) do { asm volatile("s_waitcnt lgkmcnt(" #n ")" ::: "memory"); SBAR(); } while (0)
    s16x4 h0l, h0h, h1l, h1h, h2l, h2h, h3l, h3h, h4l, h4h;
    PV_RH(0, h0l, h0h); PV_RH(1, h1l, h1h); PV_RH(2, h2l, h2h); PV_RH(3, h3l, h3h); PV_RH(4, h4l, h4h); SBAR();
    PV_WN(8); PV_M1(0, pa0, h0l, h0h); SBAR(); PV_RH(5, h0l, h0h); SBAR();
    PV_WN(8); PV_M1(1, pa1, h1l, h1h); SBAR(); PV_RH(6, h1l, h1h); SBAR();
    PV_WN(8); PV_M1(2, pa2, h2l, h2h); SBAR(); PV_RH(7, h2l, h2h); SBAR();
    PV_WN(8); PV_M1(3, pa3, h3l, h3h); SBAR(); PV_RH(8, h3l, h3h); SBAR();
    PV_WN(8); PV_M1(4, pa0, h4l, h4h); SBAR(); PV_RH(9, h4l, h4h); SBAR();
    PV_WN(8); PV_M1(5, pa1, h0l, h0h); SBAR(); PV_RH(10, h0l, h0h); SBAR();
    PV_WN(8); PV_M1(6, pa2, h1l, h1h); SBAR(); PV_RH(11, h1l, h1h); SBAR();
    PV_WN(8); PV_M1(7, pa3, h2l, h2h); SBAR(); PV_RH(12, h2l, h2h); SBAR();
    PV_WN(8); PV_M1(8, pa0, h3l, h3h); SBAR(); PV_RH(13, h3l, h3h); SBAR();
    PV_WN(8); PV_M1(9, pa1, h4l, h4h); SBAR(); PV_RH(14, h4l, h4h); SBAR();
    PV_WN(8); PV_M1(10, pa2, h0l, h0h); SBAR(); PV_RH(15, h0l, h0h); SBAR();
    PV_WN(8); PV_M1(11, pa3, h1l, h1h); SBAR();
    PV_WN(6); PV_M1(12, pa0, h2l, h2h); SBAR();
    PV_WN(4); PV_M1(13, pa1, h3l, h3h); SBAR();
    PV_WN(2); PV_M1(14, pa2, h4l, h4h); SBAR();
    PV_WN(0); PV_M1(15, pa3, h0l, h0h); SBAR();
#undef PV_RH
#undef PV_M1
#undef PV_WN
#undef PV_RD
#undef PV_MM
#undef PV_W4
#undef PV_W0
#undef TRRD
}

struct Group { const bf16_t* Q; const bf16_t* K; const bf16_t* V; const bf16_t* KR; const float* NC; bf16_t* O; float* SS; int qhs, khs, slot0; };
struct BlockRef { int bh, P0; float W; };
#define R_TOK(R) ((size_t)((R).bh >> 3) * SEQ)
#define R_Q(R) (G.Q + (R_TOK(R) + (R).P0) * LDQ + ((R).bh & 7) * G.qhs)
#define R_K(R) (G.K + R_TOK(R) * LDK + ((R).bh & 7) * G.khs)
#define R_V(R) (G.V + R_TOK(R) * LDV + ((R).bh & 7) * G.khs)
#define R_KR(R) (G.KR + R_TOK(R) * 64)
#define R_NC(R) (G.NC + (size_t)(R).bh * SEQ)
#define R_O(R) (G.O + (R_TOK(R) + (R).P0) * LDO + ((R).bh & 7) * 128)
#define R_Q8(R) ((const unsigned char*)G.Q + (R_TOK(R) + (R).P0) * 1536 + ((R).bh & 7) * 192)
#define R_K8(R) ((const unsigned char*)G.K + R_TOK(R) * 1024 + ((R).bh & 7) * 128)
#define R_KR8(R) ((const unsigned char*)G.KR + R_TOK(R) * 64)
#define LD16(p) (*reinterpret_cast<const bf16x8*>(p))
template <int DK> struct Seam { int jlo; bf16x8 qr[8]; i32x8 q8[3]; bf16x8 st_v0, st_v1, st_k0, st_k1, st_kr; float st_c; };

#define AT_QLOAD(R, rr, hh) do { if constexpr (DK == 192) { const unsigned char* qp_ = R_Q8(R) + (size_t)(wid * QBLK + (rr)) * 1536 + 32 * (hh); \
        _Pragma("unroll") for (int s_ = 0; s_ < 3; ++s_) S.q8[s_] = __builtin_shufflevector(__builtin_bit_cast(i32x4, LD16(qp_ + 64 * s_)), __builtin_bit_cast(i32x4, LD16(qp_ + 64 * s_ + 16)), 0, 1, 2, 3, 4, 5, 6, 7); } \
    else { _Pragma("unroll") for (int d0 = 0; d0 < 8; ++d0) S.qr[d0] = load8(R_Q(R) + (size_t)(wid * QBLK + (rr)) * LDQ + d0 * 16 + (hh) * 8); } } while (0)
#define VMW() asm volatile("s_waitcnt vmcnt(0)" ::: "memory")
#define VMWN(n) asm volatile("s_waitcnt vmcnt(%0)" :: "i"(n) : "memory")
#define AT_SLOAD(R, k0) do { S.st_v0 = load8(R_V(R) + (size_t)((k0) + sr) * LDV + sc); S.st_v1 = load8(R_V(R) + (size_t)((k0) + 32 + sr) * LDV + sc);              \
                             if constexpr (DK == 192) { S.st_k0 = LD16(R_K8(R) + (size_t)((k0) + (tid >> 3)) * 1024 + (tid & 7) * 16);                              \
                                                        if (tid < 256) S.st_kr = LD16(R_KR8(R) + (size_t)((k0) + (tid >> 2)) * 64 + (tid & 3) * 16); }            \
                             else { S.st_k0 = load8(R_K(R) + (size_t)((k0) + sr) * LDK + sc); S.st_k1 = load8(R_K(R) + (size_t)((k0) + 32 + sr) * LDK + sc); }      \
                             if constexpr (BIAS) { if (tid < 64) S.st_c = R_NC(R)[(k0) + tid]; } } while (0)
#define AT_SWRITE_K(bf) do { if constexpr (DK == 192) { *(bf16x8*)(K_lds + (bf) * SHM_K8 + (tid >> 3) * K8P + (tid & 7) * 16) = S.st_k0;                            \
                                                        if (tid < 256) *(bf16x8*)(K_lds + (bf) * SHM_K8 + (tid >> 2) * K8P + 128 + (tid & 3) * 16) = S.st_kr; }    \
                             else { *(bf16x8*)(K_lds + (bf) * SHM_K + kws) = S.st_k0; *(bf16x8*)(K_lds + (bf) * SHM_K + kws + 32 * KP) = S.st_k1; }                  \
                             if constexpr (BIAS) { if (tid < 64) ((float*)(lds + OFF_NC + (bf) * 256))[tid] = S.st_c; } } while (0)
#define AT_SWRITE_V(bf) do { *(bf16x8*)(V_lds + (bf) * SHM_V + vst0) = S.st_v0; *(bf16x8*)(V_lds + (bf) * SHM_V + vst1) = S.st_v1; } while (0)
#define AT_SWRITE_VO(off) do { *(bf16x8*)(V_lds + (off) + vst0) = S.st_v0; *(bf16x8*)(V_lds + (off) + vst1) = S.st_v1; } while (0)

template <bool BIAS>
__device__ __forceinline__ int first_tile(const Group& G, const BlockRef& R, int lane) {
    if constexpr (!BIAS) return 0;
    else { int l2 = lane; asm volatile("" : "+v"(l2));
        const float* nc = R_NC(R); const float ref = nc[R.P0], e0 = nc[128 * l2 + 63], e1 = nc[128 * l2 + 127];
        const int n = __popcll(__ballot(ref - e0 >= R.W)) + __popcll(__ballot(ref - e1 >= R.W));
        return __builtin_amdgcn_readfirstlane(n); }
}
template <int DK, bool BIAS, int LDQ, int LDK, int LDV>
__device__ __forceinline__ void prime(const Group& G, const BlockRef& cur, char* lds, Seam<DK>& S) {
    const int tid = threadIdx.x, wid = __builtin_amdgcn_readfirstlane(tid >> 6), lane = tid & 63, r32 = lane & 31, hi = lane >> 5;
    const int sr = tid >> 4, sc = (tid & 15) * 8, kws = KSWZ(sr, sc * 2), krws = KRSWZ(tid >> 3, (tid & 7) * 16); char* K_lds = lds + OFF_K;
    AT_QLOAD(cur, r32, hi);
    S.jlo = first_tile<BIAS>(G, cur, lane);
    AT_SLOAD(cur, S.jlo * KVBLK); VMW(); AT_SWRITE_K(0);
    __syncthreads();
}
template <int DK, bool BIAS, int LDQ, int LDK, int LDV>
__device__ __forceinline__ void block(const Group& G, const BlockRef& cur, const BlockRef& nxt, char* lds, Seam<DK>& S) {
    const int tid = threadIdx.x, wid = __builtin_amdgcn_readfirstlane(tid >> 6), lane = tid & 63, r32 = lane & 31, hi = lane >> 5;
    const int j_lo = S.jlo, NT = (cur.P0 + QB) / KVBLK - j_lo;
    const int jlo_n = first_tile<BIAS>(G, nxt, lane);
    const int qlo = cur.P0 + wid * QBLK, qm = qlo + r32 - 4 * hi;
    char* V_lds = lds + OFF_V; char* K_lds = lds + OFF_K;
    float* ws = (float*)(lds + OFF_WS) + wid * 64; float* li_l = ws, * al_l = ws + 32;
    float m_reg = -1e30f, l_reg = 0; f32x16 o[4] = {};
    const int sr = tid >> 4, sc = (tid & 15) * 8, vst0 = v_st(sr, sc), vst1 = v_st(32 + sr, sc), kws = KSWZ(sr, sc * 2), krws = KRSWZ(tid >> 3, (tid & 7) * 16);
    int vb0 = (int)(uintptr_t)V_lds + v_rd_base(lane);
#define RESC(a) do { if (__any((a) < 1.f)) { if (hi == 0) al_l[r32] = (a); asm volatile("s_waitcnt lgkmcnt(0)" ::: "memory");              \
                     for (int d_ = 0; d_ < 4; ++d_) for (int r = 0; r < 16; ++r) o[d_][r] *= al_l[crow(r, hi)]; } } while (0)
#define QKT(KB_, X0, X1) do { if constexpr (DK == 192) qkt8<KB_>(X0, X1, lds, r32, hi, S.q8); else qkt<KB_, DK, BIAS>(X0, X1, lds, r32, hi, S.qr); } while (0)
#define KBASE(t) ((j_lo + (t)) * KVBLK)
#define MASKT(P0_, P1_, t) do { const int kb_ = KBASE(t); if (kb_ + KVBLK - 1 > qlo) mask_tile(P0_, P1_, qm - kb_); } while (0)
    constexpr int NQL = DK == 192 ? 6 : 8;
#define SEAM_K0() do { VMWN(NQL); AT_SWRITE_K(0); SBAR(); } while (0)
    f32x16 pA0, pA1, pB0, pB1; float mnA, mnB, alA, alB; bf16x8 pa0, pa1, pa2, pa3;
    AT_SWRITE_V(0); SBAR();
    if (NT > 1) AT_SLOAD(cur, KBASE(1));
    SBAR(); QKT(0, pA0, pA1);
    MASKT(pA0, pA1, 0); partialSM<DK>(pA0, pA1, m_reg, mnA, alA);
    if (NT > 1) { VMW(); AT_SWRITE_V(1); AT_SWRITE_K(1); }
    __syncthreads();
    int va = 0, vbn = SHM_V, vc = OFF_KR - OFF_V;
#define HALF_STEP(PX0, PX1, mnX, alX, PY0, PY1, alY, t, KB, VB, SB) do {                                                      \
        SBAR(); QKT(KB, PX0, PX1);                                                              \
        finishSM(PY0, PY1, alY, l_reg, pa0, pa1, pa2, pa3); SBAR();                                                           \
        if ((t) + 1 < NT) { AT_SLOAD(cur, KBASE((t) + 1)); SBAR(); }                                                          \
        pv_tile<0>(o, vb0, pa0, pa1, pa2, pa3); MASKT(PX0, PX1, (t)); partialSM<DK>(PX0, PX1, m_reg, mnX, alX);                \
        if ((t) + 1 < NT) { VMW(); AT_SWRITE_VO(vc); AT_SWRITE_K(SB); }                                                       \
        RESC(alX); { const int t_ = va; vb0 += vbn - va; va = vbn; vbn = vc; vc = t_; } __syncthreads(); } while (0)
    for (int t = 1; t + 1 < NT; t += 2) {
        HALF_STEP(pB0, pB1, mnB, alB, pA0, pA1, alA, t, 1, 0, 0);
        HALF_STEP(pA0, pA1, mnA, alA, pB0, pB1, alB, t + 1, 0, 1, 1);
    }
    const bool even = (NT & 1) == 0;
    int l3 = threadIdx.x & 63; asm volatile("" : "+v"(l3)); const int r32t = l3 & 31, hit = l3 >> 5;
    if (even) { SBAR(); QKT(1, pB0, pB1); SBAR(); }
    AT_SLOAD(nxt, jlo_n * KVBLK); SBAR();
    AT_QLOAD(nxt, r32t, hit);
    SBAR();
    finishSM(pA0, pA1, alA, l_reg, pa0, pa1, pa2, pa3); SBAR();
    pv_tile<0>(o, vb0, pa0, pa1, pa2, pa3);
    if (even) { MASKT(pB0, pB1, NT - 1); partialSM<DK>(pB0, pB1, m_reg, mnB, alB); __syncthreads(); RESC(alB);
        finishSM(pB0, pB1, alB, l_reg, pa0, pa1, pa2, pa3); SBAR(); vb0 += vbn - va; pv_tile<0>(o, vb0, pa0, pa1, pa2, pa3); }
    SBAR(); SEAM_K0();
    if (hi == 0) li_l[r32] = l_reg; asm volatile("s_waitcnt lgkmcnt(0)" ::: "memory");
    float rli[16];
#pragma unroll
    for (int r = 0; r < 16; ++r) rli[r] = __builtin_amdgcn_rcpf(li_l[crow(r, hi)]);
    bf16_t* Ow = R_O(cur) + (size_t)(wid * QBLK) * LDO;
    { float* ssp = G.SS + (R_TOK(cur) + cur.P0 + wid * QBLK) * 16 + G.slot0 + (cur.bh & 7);
#pragma unroll
      for (int r = 0; r < 16; ++r) { float q = 0.f;
#pragma unroll
          for (int d0 = 0; d0 < 4; ++d0) { const float v = o[d0][r] * rli[r]; q += v * v; }
#pragma unroll
          for (int of = 1; of < 32; of <<= 1) q += __shfl_xor(q, of);
          if (r32t == 0) ssp[(size_t)crow(r, hit) * 16] = q; } }
#pragma unroll
    for (int r = 0; r < 16; ++r) { const int orow = crow(r, hit);
#pragma unroll
        for (int d0 = 0; d0 < 4; ++d0) { const float v = o[d0][r] * rli[r];
            const float vn = __shfl_xor(v, 1);
            if ((r32t & 1) == 0) *(unsigned*)(Ow + (size_t)orow * LDO + d0 * 32 + r32t) = cvt_pk_bf16(v, vn); } }
    S.jlo = jlo_n;
    __syncthreads();
#undef RESC
#undef KBASE
#undef QKT
#undef MASKT
#undef SEAM_K0
#undef HALF_STEP
}
#undef VMW
#undef VMWN
#undef AT_SLOAD
#undef AT_QLOAD
#undef LD16
#undef R_Q8
#undef R_K8
#undef R_KR8
#undef AT_SWRITE_K
#undef AT_SWRITE_V
#undef AT_SWRITE_VO
#undef R_TOK
#undef R_Q
#undef R_K
#undef R_V
#undef R_KR
#undef R_NC
#undef R_O
}

static_assert(att::LDS_BYTES <= RING_BYTES && pg8::STAGE_BYTES <= RING_BYTES && TAB_OFF + 72 * 4 <= LDS_BYTES, "LDS map");
struct Args { const float* in[19]; float* out; unsigned char* ws; int ph_lo, ph_hi; };
struct Frame {
    LAS unsigned char* lds; volatile LAS unsigned* MISC; gu32* ctl; unsigned char* ws;
    int tid, lane, wave, vcu, G;
};

template <int KT, int NT, bool FP8, class Map>
__device__ __forceinline__ void tr_tile(const float* W, int K, int N, void* WT, const float* gain, LAS float* scr, int item, int lane, Map dmap) {
    constexpr int LR = NT / 4, RPI = 64 / LR, NI = KT / RPI, P = NT + 1;
    const int nblk = (N + NT - 1) / NT, kb = item / nblk, nb = item % nblk, k0 = KT * kb, n0 = NT * nb;
    const int lr = lane / LR, lc = (lane % LR) * 4, cc = n0 + lc;
    f32x4 v[NI];
#pragma unroll
    for (int i = 0; i < NI; ++i) { v[i] = (f32x4){0.f, 0.f, 0.f, 0.f}; if (cc < N) v[i] = __builtin_nontemporal_load((const GAS f32x4*)(W + (size_t)(k0 + i * RPI + lr) * N + cc)); }
#pragma unroll
    for (int i = 0; i < NI; ++i) { const int kk = i * RPI + lr; float g = FP8 ? 64.f : 1.f; if (gain) g *= gain[k0 + kk];
        LAS float* d = scr + kk * P + lc; d[0] = v[i][0] * g; d[1] = v[i][1] * g; d[2] = v[i][2] * g; d[3] = v[i][3] * g; }
    LDS_WAIT(); asm volatile("" ::: "memory");
    const int c = lane & 7;
#pragma unroll
    for (int j = 0; j < NT / 8; ++j) { const int n = (lane >> 3) + 8 * j;
        if (n0 + n < N) { const int d = dmap(n0 + n);
            if (d >= 0) {
                if constexpr (FP8) { const LAS float* t = scr + (16 * c) * P + n; u32x4 o;
#pragma unroll
                    for (int q = 0; q < 4; ++q) { unsigned w = 0u; w = __builtin_amdgcn_cvt_pk_fp8_f32(t[(4 * q) * P], t[(4 * q + 1) * P], w, false); w = __builtin_amdgcn_cvt_pk_fp8_f32(t[(4 * q + 2) * P], t[(4 * q + 3) * P], w, true); o[q] = w; }
                    *(GAS u32x4*)((unsigned char*)WT + (size_t)d * K + k0 + 16 * c) = o; }
                else { const LAS float* t = scr + (8 * c) * P + n; u32x4 o; o.x = pk2(t[0 * P], t[1 * P]); o.y = pk2(t[2 * P], t[3 * P]); o.z = pk2(t[4 * P], t[5 * P]); o.w = pk2(t[6 * P], t[7 * P]);
                    *(GAS u32x4*)((bf16_t*)WT + (size_t)d * K + k0 + 8 * c) = o; } } } }
    LDS_WAIT(); asm volatile("" ::: "memory");
}
struct ExpItem { const float* W; unsigned char* WT; const float* gain; int N, k0, n0; bool gu; };
__device__ __forceinline__ void exp_load(const ExpItem& I, int lane, f32x4 (&v)[16]) {
    const int lr = lane >> 3, lc = (lane & 7) * 4;
#pragma unroll
    for (int i = 0; i < 16; ++i) v[i] = __builtin_nontemporal_load((const GAS f32x4*)(I.W + (size_t)(I.k0 + i * 8 + lr) * I.N + I.n0 + lc));
}
__device__ __forceinline__ void exp_finish(const ExpItem& I, int lane, LAS float* scr, const f32x4 (&v)[16]) {
    constexpr int P = 33; const int lr = lane >> 3, lc = (lane & 7) * 4;
#pragma unroll
    for (int i = 0; i < 16; ++i) { const int kk = i * 8 + lr; float g = 64.f; if (I.gain) g *= I.gain[I.k0 + kk];
        LAS float* d = scr + kk * P + lc; d[0] = v[i][0] * g; d[1] = v[i][1] * g; d[2] = v[i][2] * g; d[3] = v[i][3] * g; }
    LDS_WAIT(); asm volatile("" ::: "memory");
    const int c = lane & 7;
#pragma unroll
    for (int j = 0; j < 4; ++j) { const int n = (lane >> 3) + 8 * j, col = I.n0 + n; const int d = I.gu ? (((col & 2047) >> 7) * 256 + (col >> 11) * 128 + (col & 127)) : col;
        const LAS float* t = scr + (16 * c) * P + n; u32x4 o;
#pragma unroll
        for (int q = 0; q < 4; ++q) { unsigned w = 0u; w = __builtin_amdgcn_cvt_pk_fp8_f32(t[(4 * q) * P], t[(4 * q + 1) * P], w, false); w = __builtin_amdgcn_cvt_pk_fp8_f32(t[(4 * q + 2) * P], t[(4 * q + 3) * P], w, true); o[q] = w; }
        *(GAS u32x4*)(I.WT + (size_t)d * DM + I.k0 + 16 * c) = o; }
    LDS_WAIT(); asm volatile("" ::: "memory");
}
struct MapId { __device__ __forceinline__ int operator()(int c) const { return c; } };
struct MapWin {
    __device__ __forceinline__ int operator()(int c) const {
        if (c < 1024) return c;
        if (c < 1088) { const int i = c - 1024; return 4096 + (i < 32 ? 2 * i : 2 * (i - 32) + 1); }
        if (c < 4160) return c - 64;
        return 4160 + (c - 4160);
    }
};
struct MapWq {
    __device__ __forceinline__ int operator()(int c) const { const int h = c / 192, j = c % 192; if (j < 128) return c; const int i = j - 128; return h * 192 + 128 + (i < 32 ? 2 * i : 2 * (i - 32) + 1); }
};
struct MapGu {
    __device__ __forceinline__ int operator()(int c) const { const int f = c & 2047; return (f >> 7) * 256 + (c >> 11) * 128 + (f & 127); }
};

__device__ __forceinline__ void p0_prologue(Frame& F, const Args& a) {
    LAS float* scr = (LAS float*)(F.lds + F.wave * 16896);
    const int gw = F.vcu * NWAVES + F.wave, NGW = F.G * NWAVES;
    const float* x = a.in[0]; const float* g_attn = a.in[1]; const float* w_in = a.in[2]; const float* g_q_a = a.in[3]; const float* w_q_b = a.in[4];
    const float* g_kv_a = a.in[5]; const float* w_kv_b = a.in[6]; const float* g_mla = a.in[8]; const float* g_fox = a.in[9]; const float* w_o = a.in[10];
    const float* g_ffn = a.in[11]; const float* w_router = a.in[12]; const float* w_gu = a.in[14]; const float* w_dn = a.in[16];
    bf16_t* WIN = (bf16_t*)(F.ws + WS_WIN); bf16_t* WQB = (bf16_t*)(F.ws + WS_WQB); bf16_t* WKVB = (bf16_t*)(F.ws + WS_WKVB); bf16_t* WO = (bf16_t*)(F.ws + WS_WO);
    bf16_t* HN = (bf16_t*)(F.ws + WS_HN);
    constexpr int I_GU1 = USE_FP8 ? (DM / 128) * (4096 / 32) : (DM / 64) * (4096 / 64), I_GU = NE * I_GU1, I_DN1 = USE_FP8 ? (DM / 128) * (DM / 32) : (DM / 64) * (DM / 64), I_DN = NE * I_DN1;
    constexpr int I_IN = FP8D ? (DM / 128) * ((NIN + 31) / 32) : (DM / 64) * ((NIN + 63) / 64), I_QB = (512 / 64) * (QW / 64), I_KVB = (512 / 64) * (KVW / 64), I_O = FP8O ? (DM / 128) * (DM / 32) : (DM / 64) * (DM / 64);
    constexpr int NITEMS = I_GU + I_DN + I_IN + I_QB + I_KVB + I_O;
    constexpr int WB = USE_FP8 ? 1 : 2;
    unsigned char* WGU = F.ws + WS_WGU; unsigned char* WDN = F.ws + WS_WDN;
    if constexpr (USE_FP8) {
        auto decode = [&](int r) { ExpItem I; I.gu = r < I_GU; const int q = I.gu ? r : r - I_GU, per = I.gu ? I_GU1 : I_DN1, e = q / per, it = q % per; I.N = I.gu ? 4096 : DM;
            const int nblk = I.N / 32; I.k0 = 128 * (it / nblk); I.n0 = 32 * (it % nblk); I.W = (I.gu ? w_gu : w_dn) + (size_t)e * DM * I.N; I.WT = (I.gu ? WGU : WDN) + (size_t)e * I.N * DM; I.gain = I.gu ? g_ffn : nullptr; return I; };
        f32x4 va[16], vb[16]; int r = gw;
        if (r < I_GU + I_DN) exp_load(decode(r), F.lane, va);
        while (r < I_GU + I_DN) {
            const int r1 = r + NGW; if (r1 < I_GU + I_DN) exp_load(decode(r1), F.lane, vb);
            exp_finish(decode(r), F.lane, scr, va);
            if (r1 >= I_GU + I_DN) break;
            const int r2 = r1 + NGW; if (r2 < I_GU + I_DN) exp_load(decode(r2), F.lane, va);
            exp_finish(decode(r1), F.lane, scr, vb);
            r = r2;
        }
    }
    for (int it = gw + (USE_FP8 ? ((I_GU + I_DN - gw + NGW - 1) / NGW) * NGW : 0); it < NITEMS; it += NGW) {
        int r = it;
        if constexpr (!USE_FP8) {
        if (r < I_GU) { const int e = r / I_GU1; const float* src = w_gu + (size_t)e * DM * 4096; unsigned char* dst = WGU + (size_t)e * 4096 * DM * WB;
            tr_tile<64, 64, false>(src, DM, 4096, dst, g_ffn, scr, r % I_GU1, F.lane, MapGu()); continue; }
        if (r < I_GU + I_DN) { const int q = r - I_GU, e = q / I_DN1; const float* src = w_dn + (size_t)e * DM * DM; unsigned char* dst = WDN + (size_t)e * DM * DM * WB;
            tr_tile<64, 64, false>(src, DM, DM, dst, nullptr, scr, q % I_DN1, F.lane, MapId()); continue; }
        }
        r -= I_GU + I_DN;
        if (r < I_IN) { if constexpr (FP8D) tr_tile<128, 32, true>(w_in, DM, NIN, WIN, nullptr, scr, r, F.lane, MapWin()); else tr_tile<64, 64, false>(w_in, DM, NIN, WIN, nullptr, scr, r, F.lane, MapWin()); continue; } r -= I_IN;
        if (r < I_QB) { tr_tile<64, 64, false>(w_q_b, 512, QW, WQB, g_q_a, scr, r, F.lane, MapWq()); continue; } r -= I_QB;
        if (r < I_KVB) { tr_tile<64, 64, false>(w_kv_b, 512, KVW, WKVB, g_kv_a, scr, r, F.lane, MapId()); continue; } r -= I_KVB;
        if constexpr (FP8O) { const int kb = r / (DM / 32); tr_tile<128, 32, true>(w_o, DM, DM, WO, (128 * kb < 1024) ? g_mla + 0 : g_fox - 1024, scr, r, F.lane, MapId()); }
        else { const int kb = r / (DM / 64); tr_tile<64, 64, false>(w_o, DM, DM, WO, (64 * kb < 1024) ? g_mla + 0 : g_fox - 1024, scr, r, F.lane, MapId()); }
    }
    { const int gt = F.vcu * 512 + F.tid, NT_ = F.G * 512; u32x4 z = {0u, 0u, 0u, 0u};
      constexpr int EB = FP8D ? 1 : 2;
      for (int i = gt; i < (4352 - 4168) * DM * EB / 16; i += NT_) *(GAS u32x4*)((unsigned char*)WIN + (size_t)4168 * DM * EB + (size_t)i * 16) = z; }
    { const int gt = F.vcu * 512 + F.tid, NT_ = F.G * 512; float* WR = (float*)(F.ws + WS_WR);
      for (int i = gt; i < DM * NE; i += NT_) WR[i] = w_router[i] * g_ffn[i >> 5]; }
    { const int gt = F.vcu * 512 + F.tid, NT_ = F.G * 512; f32x2* RT = (f32x2*)(F.ws + WS_ROPE);
      const float invf = (float)exp2(-(double)(gt & 31) * (13.287712379549449 / 32.0));
      for (int i = gt; i < SEQ * 32; i += NT_) {
          const int pos = i >> 5;
          const float ang = (float)pos * invf;
          double rev = (double)ang * 0.15915494309189535; rev -= __builtin_floor(rev + 0.5);
          const double r = rev * 6.283185307179586, r2 = r * r;
          double sn = 1.0, cs = 1.0;
#pragma unroll
          for (int n = 13; n >= 1; --n) sn = 1.0 - sn * r2 * (1.0 / (double)((2 * n) * (2 * n + 1)));
#pragma unroll
          for (int n = 14; n >= 1; --n) cs = 1.0 - cs * r2 * (1.0 / (double)((2 * n - 1) * (2 * n)));
          RT[i] = (f32x2){(float)cs, (float)(sn * r)};
      } }
    for (int m = gw; m < T; m += NGW) {
        const GAS f32x4* xr = (const GAS f32x4*)(x + (size_t)m * DM) + F.lane;
        f32x4 v[8]; float s = 0.f;
#pragma unroll
        for (int j = 0; j < 8; ++j) { v[j] = xr[64 * j]; s += (v[j].x * v[j].x + v[j].y * v[j].y) + (v[j].z * v[j].z + v[j].w * v[j].w); }
        const float rstd = 1.f / sqrtf(wave_sum(s) * (1.f / DM) + EPS);
        GAS u32x2* o8 = (GAS u32x2*)(HN + (size_t)m * DM) + F.lane; GAS unsigned* o4 = (GAS unsigned*)((unsigned char*)HN + (size_t)m * DM) + F.lane;
#pragma unroll
        for (int j = 0; j < 8; ++j) { const f32x4 g = *((const GAS f32x4*)g_attn + 64 * j + F.lane); const f32x4 y = {v[j].x * rstd * g.x, v[j].y * rstd * g.y, v[j].z * rstd * g.z, v[j].w * rstd * g.w};
            if constexpr (FP8D) { unsigned w = 0u; w = __builtin_amdgcn_cvt_pk_fp8_f32(y[0], y[1], w, false); w = __builtin_amdgcn_cvt_pk_fp8_f32(y[2], y[3], w, true); o4[64 * j] = w; }
            else o8[64 * j] = (u32x2){pk2(y[0], y[1]), pk2(y[2], y[3])}; }
    }
}

using pg8::Unit; using pg8::uni; using pg8::ald;
typedef f32x4 Acc[2][2][4][2];
__device__ __forceinline__ u32x4 pack8v(f32x4 a, f32x4 b) { u32x4 w; w.x = cvt_pk_bf16(a[0], a[1]); w.y = cvt_pk_bf16(a[2], a[3]); w.z = cvt_pk_bf16(b[0], b[1]); w.w = cvt_pk_bf16(b[2], b[3]); return w; }
__device__ __forceinline__ f32x4 rope4(f32x4 v, f32x2 cs0, f32x2 cs1) {
    return (f32x4){v[0] * cs0.x - v[1] * cs0.y, v[1] * cs0.x + v[0] * cs0.y, v[2] * cs1.x - v[3] * cs1.y, v[3] * cs1.x + v[2] * cs1.y};
}
constexpr float WSC = FP8D ? 0.015625f : 1.f;
struct EpiP1 {
    static constexpr bool SIDE = false, SIDE2 = false, MIDK = false;
    static constexpr int NSTORE = 0;
    static constexpr bool PERM = true;
    bf16_t* PROJ; bf16_t* KR; float* FL; float* ssq; const f32x2* rope; float* nrmp;
    __device__ __forceinline__ void operator()(const Acc& acc, const Unit& u, int wr, int wc, int fr, int fq) const {
        const int row0 = u.pm * 256 + wr * 64 + fr;
        if (u.pn < 16) {
            const int col0 = u.pn * 256 + wc * 32 + 8 * fq;
#pragma unroll
            for (int ai = 0; ai < 2; ++ai)
#pragma unroll
                for (int m = 0; m < 4; ++m) { const int row = row0 + ai * 128 + m * 16; bf16_t* rowp = PROJ + (size_t)row * PW + col0; float sb[2];
#pragma unroll
                    for (int bj = 0; bj < 2; ++bj) { const f32x4 v0 = acc[ai][bj][m][0] * WSC, v1 = acc[ai][bj][m][1] * WSC;
                        sb[bj] = (v0[0] * v0[0] + v0[1] * v0[1]) + (v0[2] * v0[2] + v0[3] * v0[3]) + (v1[0] * v1[0] + v1[1] * v1[1]) + (v1[2] * v1[2] + v1[3] * v1[3]);
                        *(u32x4*)(rowp + bj * 128) = pack8v(v0, v1); }
                    if (u.pn < 4) { float s = sb[0] + sb[1]; s += __shfl_xor(s, 16); s += __shfl_xor(s, 32); if (fq == 0) ssq[((size_t)(u.pn >> 1) * T + row) * 8 + (u.pn & 1) * 4 + wc] = s; }
                    else if (u.pn < 12) {
#pragma unroll
                        for (int bj = 0; bj < 2; ++bj) { float t = sb[bj]; t += __shfl_xor(t, 16); t += __shfl_xor(t, 32);
                            if (fq == 0) nrmp[((((size_t)((u.pn - 4) >> 2) * T + row) * 8) + 2 * ((u.pn - 4) & 3) + bj) * 4 + wc] = t; } } }
        } else {
#pragma unroll
            for (int ai = 0; ai < 2; ++ai)
#pragma unroll
                for (int m = 0; m < 4; ++m) { const int row = row0 + ai * 128 + m * 16; const f32x4 v0 = acc[ai][0][m][0] * WSC, v1 = acc[ai][0][m][1] * WSC;
                    if (wc < 2) { const int c = wc * 32 + 8 * fq; const f32x2* rt = rope + (size_t)(row & (SEQ - 1)) * 32 + (c >> 1);
                        *(u32x2*)((unsigned char*)KR + (size_t)row * 64 + c) = pack8f8(rope4(v0, rt[0], rt[1]), rope4(v1, rt[2], rt[3])); }
                    else if (wc == 2 && fq == 0) { *(f32x4*)(FL + (size_t)row * 8) = v0; *(f32x4*)(FL + (size_t)row * 8 + 4) = v1; } }
        }
    }
};
struct EpiQ {
    static constexpr bool SIDE = false, SIDE2 = false, MIDK = false;
    static constexpr int NSTORE = 0;
    static constexpr bool PERM = true;
    bf16_t* Q; const float* ssq; const f32x2* rope;
    __device__ __forceinline__ void operator()(const Acc& acc, const Unit& u, int wr, int wc, int fr, int fq) const {
        const int row0 = u.pm * 256 + wr * 64 + fr, col0 = u.pn * 256 + wc * 32 + 8 * fq;
#pragma unroll
        for (int ai = 0; ai < 2; ++ai)
#pragma unroll
            for (int m = 0; m < 4; ++m) { const int row = row0 + ai * 128 + m * 16; const f32x4 sa = *(const f32x4*)(ssq + (size_t)row * 8), sb = *(const f32x4*)(ssq + (size_t)row * 8 + 4);
                const float rs = 1.f / sqrtf((((sa[0] + sa[1]) + (sa[2] + sa[3])) + ((sb[0] + sb[1]) + (sb[2] + sb[3]))) * (1.f / 512.f) + EPS);
#pragma unroll
                for (int bj = 0; bj < 2; ++bj) { const int c = col0 + bj * 128, j = c % 192; f32x4 v0 = acc[ai][bj][m][0] * rs, v1 = acc[ai][bj][m][1] * rs;
                    if (j >= 128) { const f32x2* rt = rope + (size_t)(row & (SEQ - 1)) * 32 + ((j - 128) >> 1); v0 = rope4(v0, rt[0], rt[1]); v1 = rope4(v1, rt[2], rt[3]); }
                    *(u32x2*)((unsigned char*)Q + (size_t)row * QW + c) = pack8f8(v0, v1); } }
    }
};
struct EpiKV {
    static constexpr bool SIDE = false, SIDE2 = false, MIDK = false;
    static constexpr int NSTORE = 0;
    static constexpr bool PERM = true;
    bf16_t* KV; const float* ssq; unsigned char* K8;
    __device__ __forceinline__ void operator()(const Acc& acc, const Unit& u, int wr, int wc, int fr, int fq) const {
        const int row0 = u.pm * 256 + wr * 64 + fr, col0 = u.pn * 256 + wc * 32 + 8 * fq;
#pragma unroll
        for (int ai = 0; ai < 2; ++ai)
#pragma unroll
            for (int m = 0; m < 4; ++m) { const int row = row0 + ai * 128 + m * 16; const f32x4 sa = *(const f32x4*)(ssq + (size_t)row * 8), sb = *(const f32x4*)(ssq + (size_t)row * 8 + 4);
                const float rs = 1.f / sqrtf((((sa[0] + sa[1]) + (sa[2] + sa[3])) + ((sb[0] + sb[1]) + (sb[2] + sb[3]))) * (1.f / 512.f) + EPS);
                *(u32x2*)(K8 + (size_t)row * 1024 + u.pn * 128 + wc * 32 + 8 * fq) = pack8f8(acc[ai][0][m][0] * rs, acc[ai][0][m][1] * rs);
                *(u32x4*)(KV + (size_t)row * KVW + col0 + 128) = pack8v(acc[ai][1][m][0] * rs, acc[ai][1][m][1] * rs); }
    }
};
struct EpiWo {
    static constexpr bool SIDE = true, SIDE2 = true, MIDK = true;
    static constexpr int NSTORE = 0;
    static constexpr bool PERM = true;
    const float* x; float* H1; unsigned char* XB; const float* RR;
    __device__ __forceinline__ void side_load(unsigned (&d)[2], const Unit& u, int t) const { ald(d[0], uni((const char*)RR), (unsigned)(u.pm * 256 + t) * 8u); ald(d[1], uni((const char*)RR), (unsigned)(u.pm * 256 + t) * 8u + 4u); }
    __device__ __forceinline__ void midk(Acc& acc, int wr, int fr, const LAS float* tab) const {
#pragma unroll
        for (int ai = 0; ai < 2; ++ai)
#pragma unroll
            for (int m = 0; m < 4; ++m) { const float rt = tab[wr * 64 + fr + ai * 128 + m * 16];
#pragma unroll
                for (int bj = 0; bj < 2; ++bj) { acc[ai][bj][m][0] *= rt; acc[ai][bj][m][1] *= rt; } }
    }
    __device__ __forceinline__ void operator()(const Acc& acc, const Unit& u, int wr, int wc, int fr, int fq, const LAS float* tab) const {
        const int row0 = u.pm * 256 + wr * 64 + fr, col0 = u.pn * 256 + wc * 32 + 8 * fq;
        f32x4 xa[4][2][2];
#define EW_LOAD(X, ai) do { _Pragma("unroll") for (int m = 0; m < 4; ++m) { const size_t off = (size_t)(row0 + (ai) * 128 + m * 16) * DM + col0; \
            _Pragma("unroll") for (int bj = 0; bj < 2; ++bj) { X[m][bj][0] = *(const f32x4*)(x + off + bj * 128); X[m][bj][1] = *(const f32x4*)(x + off + bj * 128 + 4); } } } while (0)
#define EW_ADD(X, ai) do { _Pragma("unroll") for (int m = 0; m < 4; ++m) { const float rf = tab[256 + wr * 64 + fr + (ai) * 128 + m * 16] * (FP8O ? 0.015625f : 1.f); \
            _Pragma("unroll") for (int bj = 0; bj < 2; ++bj) { X[m][bj][0] += acc[ai][bj][m][0] * rf; X[m][bj][1] += acc[ai][bj][m][1] * rf; } } } while (0)
#define EW_STORE(X, ai) do { _Pragma("unroll") for (int m = 0; m < 4; ++m) { const size_t off = (size_t)(row0 + (ai) * 128 + m * 16) * DM + col0; \
            _Pragma("unroll") for (int bj = 0; bj < 2; ++bj) { *(f32x4*)(H1 + off + bj * 128) = X[m][bj][0]; *(f32x4*)(H1 + off + bj * 128 + 4) = X[m][bj][1]; \
                if constexpr (USE_FP8) *(u32x2*)(XB + off + bj * 128) = pack8f8(X[m][bj][0], X[m][bj][1]); else *(u32x4*)(XB + 2 * (off + bj * 128)) = pack8v(X[m][bj][0], X[m][bj][1]); } } } while (0)
        EW_LOAD(xa, 0); asm volatile("" ::: "memory");
        EW_ADD(xa, 0);  EW_STORE(xa, 0); asm volatile("" ::: "memory");
        EW_LOAD(xa, 1); asm volatile("" ::: "memory");
        EW_ADD(xa, 1);  EW_STORE(xa, 1);
#undef EW_LOAD
#undef EW_ADD
#undef EW_STORE
    }
};
__device__ __forceinline__ f32x2 swiglu2(f32x2 g, f32x2 u1) {
    g = __builtin_elementwise_min(g, (f32x2){7.f, 7.f});
    u1 = __builtin_elementwise_min(__builtin_elementwise_max(u1, (f32x2){-6.f, -6.f}), (f32x2){8.f, 8.f});
    const f32x2 t = g * (f32x2){-1.702f * 1.4426950408889634f, -1.702f * 1.4426950408889634f};
    const f32x2 d = (f32x2){__builtin_amdgcn_exp2f(t.x), __builtin_amdgcn_exp2f(t.y)} + (f32x2){1.f, 1.f};
    const f32x2 sg = {__builtin_amdgcn_rcpf(d.x), __builtin_amdgcn_rcpf(d.y)};
    return (g * sg) * u1;
}
__device__ __forceinline__ float swiglu1(float g, float u) {
    g = fminf(g, 7.f); u = fminf(fmaxf(u, -7.f), 7.f);
    const float sg = __builtin_amdgcn_rcpf(1.f + __builtin_amdgcn_exp2f(-1.702f * 1.4426950408889634f * g));
    return g * sg * (u + 1.f);
}
struct EpiGU {
    static constexpr bool SIDE = true, SIDE2 = true, MIDK = false;
    static constexpr int NSTORE = 8;
    static constexpr bool PERM = true;
    unsigned char* H; const float* bgu; const float* listr; const LAS int* tstart;
    __device__ __forceinline__ void side_load(unsigned (&d)[2], const Unit& u, int t) const {
        ald(d[0], uni((const char*)bgu), (unsigned)(u.e * 4096 + (t >> 7) * 2048 + u.pn * 128 + (t & 127)) * 4u); ald(d[1], uni((const char*)listr), (unsigned)(u.e * LIST_CAP + (u.pm - tstart[u.e]) * 256 + t) * 4u); }
    __device__ __forceinline__ void operator()(const Acc& acc, const Unit& u, int wr, int wc, int fr, int fq, const LAS float* tab) const {
        const int c0 = wc * 32 + 8 * fq, f0 = u.pn * 128 + c0;
        const f32x4 bg0 = *(const LAS f32x4*)(tab + c0), bg1 = *(const LAS f32x4*)(tab + c0 + 4), bu0 = *(const LAS f32x4*)(tab + 128 + c0) + 1.f, bu1 = *(const LAS f32x4*)(tab + 128 + c0 + 4) + 1.f;
#define GU_LO(v) __builtin_shufflevector(v, v, 0, 1)
#define GU_HI(v) __builtin_shufflevector(v, v, 2, 3)
#pragma unroll
        for (int ai = 0; ai < 2; ++ai)
#pragma unroll
            for (int m = 0; m < 4; ++m) { const int lr = wr * 64 + fr + ai * 128 + m * 16; const float rs = tab[256 + lr] * (USE_FP8 ? 0.015625f : 1.f); const f32x2 rs2 = {rs, rs};
                const f32x2 ha = swiglu2(GU_LO(acc[ai][0][m][0]) * rs2 + GU_LO(bg0), GU_LO(acc[ai][1][m][0]) * rs2 + GU_LO(bu0)), hb = swiglu2(GU_HI(acc[ai][0][m][0]) * rs2 + GU_HI(bg0), GU_HI(acc[ai][1][m][0]) * rs2 + GU_HI(bu0));
                const f32x2 hc = swiglu2(GU_LO(acc[ai][0][m][1]) * rs2 + GU_LO(bg1), GU_LO(acc[ai][1][m][1]) * rs2 + GU_LO(bu1)), hd = swiglu2(GU_HI(acc[ai][0][m][1]) * rs2 + GU_HI(bg1), GU_HI(acc[ai][1][m][1]) * rs2 + GU_HI(bu1));
                const f32x4 h0 = __builtin_shufflevector(ha, hb, 0, 1, 2, 3), h1 = __builtin_shufflevector(hc, hd, 0, 1, 2, 3);
                const size_t ho = (size_t)(u.pm * 256 + lr) * DM + f0;
                if constexpr (USE_FP8) *(u32x2*)(H + ho) = pack8f8(h0, h1); else *(u32x4*)(H + 2 * ho) = pack8v(h0, h1); }
    }
};
struct EpiDn {
    static constexpr bool SIDE = true, SIDE2 = false, MIDK = false;
    static constexpr int NSTORE = 16;
    static constexpr bool PERM = true;
    unsigned char* Y; const float* bdn;
    __device__ __forceinline__ void side_load(unsigned (&d)[2], const Unit& u, int t) const { ald(d[0], uni((const char*)bdn), (unsigned)(u.e * DM + u.pn * 256 + t) * 4u); }
    __device__ __forceinline__ void operator()(const Acc& acc, const Unit& u, int wr, int wc, int fr, int fq, const LAS float* tab) const {
        const int row0 = u.pm * 256 + wr * 64 + fr, c0 = wc * 32 + 8 * fq, col0 = u.pn * 256 + c0;
        f32x4 bv[2][2];
#pragma unroll
        for (int bj = 0; bj < 2; ++bj)
#pragma unroll
            for (int n = 0; n < 2; ++n) bv[bj][n] = *(const LAS f32x4*)(tab + c0 + bj * 128 + 4 * n);
        constexpr float SC = (USE_FP8 ? 0.015625f : 1.f) * (MK_DUP == 101 ? 0.5f : 1.f);
#pragma unroll
        for (int ai = 0; ai < 2; ++ai)
#pragma unroll
            for (int m = 0; m < 4; ++m) { unsigned char* rowp = Y + (size_t)(row0 + ai * 128 + m * 16) * DM + col0;
#pragma unroll
                for (int bj = 0; bj < 2; ++bj) *(u32x2*)(rowp + bj * 128) = pack8f8(acc[ai][bj][m][0] * SC + bv[bj][0], acc[ai][bj][m][1] * SC + bv[bj][1]); }
    }
};

__device__ __forceinline__ void p2_cumsum(Frame& F, const Args& a) {
    const float* FL = (const float*)(F.ws + WS_FL); float* NC = (float*)(F.ws + WS_CUM); const float* b_forget = a.in[7];
    LAS double* part = (LAS double*)F.lds;
    for (int sq = F.vcu; sq < NB * 8; sq += F.G) {
        const int b = sq >> 3, h = sq & 7; const float bf = b_forget[h];
        const float* src = FL + ((size_t)b * SEQ + (size_t)F.tid * 16) * 8 + h;
        float lv[16]; double run = 0.0;
#pragma unroll
        for (int j = 0; j < 16; ++j) lv[j] = src[(size_t)j * 8];
#pragma unroll
        for (int j = 0; j < 16; ++j) { const float xx = lv[j] + bf; lv[j] = fminf(xx, 0.f) - __logf(1.f + __expf(-fabsf(xx))); run += (double)lv[j]; }
        double incl = run;
#pragma unroll
        for (int o = 1; o < 64; o <<= 1) { const double up = __shfl_up(incl, o); if (F.lane >= o) incl += up; }
        if (F.lane == 63) part[F.wave] = incl;
        __syncthreads();
        double acc = incl - run;
        for (int w = 0; w < F.wave; ++w) acc += part[w];
        float* dst = NC + (size_t)sq * SEQ + (size_t)F.tid * 16;
#pragma unroll
        for (int j = 0; j < 16; ++j) { acc += (double)lv[j]; dst[j] = (float)(-11.313708498984761 * acc); }
        __syncthreads();
    }
}

__device__ __forceinline__ void p2_norms(Frame& F) {
    const f32x4* NP = (const f32x4*)(F.ws + WS_NRMP); gu32* nrm = F.ctl + CW_NRM;
    LAS float* red = (LAS float*)(F.lds + 1024);
    const int hs = F.lane & 15, sub = F.lane >> 4;
    constexpr int RPW = 16, RPG = RPW * NWAVES;
    for (int r0 = F.vcu * RPG; r0 < T; r0 += F.G * RPG) {
        float m = 0.f;
#pragma unroll
        for (int k = 0; k < RPW / 4; ++k) { const int row = r0 + F.wave * RPW + 4 * k + sub;
            const f32x4 v = NP[((size_t)(hs >> 3) * T + row) * 8 + (hs & 7)]; m = fmaxf(m, (v[0] + v[1]) + (v[2] + v[3])); }
        m = fmaxf(m, __shfl_xor(m, 16)); m = fmaxf(m, __shfl_xor(m, 32));
        if (F.lane < 16) red[F.wave * 16 + hs] = m;
        __syncthreads();
        if (F.tid < 16) { float mm = red[F.tid];
#pragma unroll
            for (int w = 1; w < NWAVES; ++w) mm = fmaxf(mm, red[w * 16 + F.tid]);
            const int bh = (r0 / SEQ) * 8 + (F.tid & 7);
            __hip_atomic_fetch_max(nrm + (F.tid < 8 ? 0 : 32) + bh, __builtin_bit_cast(unsigned, mm), RLX_AGENT); }
        __syncthreads();
    }
}

template <int DK, bool BIAS, int LDQ, int LDK, int LDV>
__device__ __forceinline__ void attn_group(Frame& F, char* lds, const bf16_t* Qb, int qhs, const bf16_t* Kb, const bf16_t* Vb, int khs, const bf16_t* KRb, const float* NCb, bf16_t* Ob, int slot0) {
    const gu32* nrm = F.ctl + CW_NRM;
    const int nquad = (256 - F.vcu + F.G - 1) / F.G; if (nquad <= 0) return;
    const int nblk = nquad * 4;
    const att::Group G{Qb, Kb, Vb, KRb, NCb, Ob, (float*)(F.ws + WS_SS), qhs, khs, slot0};
    auto ref = [&](int i) { att::BlockRef R; const int quad = F.vcu + (i >> 2) * F.G, s = quad & 7, j = i & 3;
        R.bh = quad >> 3; if constexpr (BIAS) R.bh = (R.bh & ~7) | ((R.bh + 2 * j) & 7);
        R.P0 = 256 * ((j == 0) ? s : (j == 1) ? 15 - s : (j == 2) ? 16 + s : 31 - s); R.W = 0.f;
        if constexpr (BIAS) R.W = 2.f * sqrtf(__builtin_bit_cast(float, __hip_atomic_load(nrm + R.bh, RLX_AGENT)) * __builtin_bit_cast(float, __hip_atomic_load(nrm + 32 + R.bh, RLX_AGENT))) * 1.005f + 30.f * 11.313708498984761f;
        return R; };
    att::Seam<DK> S;
    att::BlockRef cur = ref(0);
    att::prime<DK, BIAS, LDQ, LDK, LDV>(G, cur, lds, S);
    for (int i = 0; i < nblk; ++i) {
        const att::BlockRef nxt = (i + 1 < nblk) ? ref(i + 1) : cur;
        att::block<DK, BIAS, LDQ, LDK, LDV>(G, cur, nxt, lds, S);
        cur = nxt;
    }
    VM_WAIT(); __syncthreads();
}

__device__ __forceinline__ void onorm_tile(Frame& F, int pm, int t256) {
    const f32x4* SS = (const f32x4*)(F.ws + WS_SS); f32x2* RR = (f32x2*)(F.ws + WS_RR);
    const int t = pm * 256 + t256;
    const f32x4 a = SS[t * 4], b = SS[t * 4 + 1], c = SS[t * 4 + 2], d = SS[t * 4 + 3];
    const float rm = 1.f / sqrtf((((a[0] + a[1]) + (a[2] + a[3])) + ((b[0] + b[1]) + (b[2] + b[3]))) * (1.f / 1024.f) + EPS);
    const float rf = 1.f / sqrtf((((c[0] + c[1]) + (c[2] + c[3])) + ((d[0] + d[1]) + (d[2] + d[3]))) * (1.f / 1024.f) + EPS);
    RR[t] = (f32x2){rm / rf, rf};
}
__device__ __forceinline__ void p4_onorm(Frame& F) {
    const f32x4* SS = (const f32x4*)(F.ws + WS_SS); f32x2* RR = (f32x2*)(F.ws + WS_RR);
    for (int t = F.vcu * 512 + F.tid; t < T; t += F.G * 512) {
        const f32x4 a = SS[t * 4], b = SS[t * 4 + 1], c = SS[t * 4 + 2], d = SS[t * 4 + 3];
        const float rm = 1.f / sqrtf((((a[0] + a[1]) + (a[2] + a[3])) + ((b[0] + b[1]) + (b[2] + b[3]))) * (1.f / 1024.f) + EPS);
        const float rf = 1.f / sqrtf((((c[0] + c[1]) + (c[2] + c[3])) + ((d[0] + d[1]) + (d[2] + d[3]))) * (1.f / 1024.f) + EPS);
        RR[t] = (f32x2){rm / rf, rf};
    }
}

__device__ __forceinline__ void p6_router(Frame& F, const Args& a) {
    const float* H1 = a.out; const float* WR = (const float*)(F.ws + WS_WR); const float* b_router = a.in[13];
    int* RE = (int*)(F.ws + WS_RE); int* RP = (int*)(F.ws + WS_RP); float* RG = (float*)(F.ws + WS_RG); int* LIST = (int*)(F.ws + WS_LIST); float* LISTR = (float*)(F.ws + WS_LISTR);
    gu32* cnt = F.ctl + CW_CNT;
    LAS float* part = (LAS float*)F.lds;
    LAS float* ssqp = (LAS float*)(F.lds + 8 * 32 * 33 * 4);
    LAS int* lcnt = (LAS int*)(F.lds + 8 * 32 * 33 * 4 + 2048);
    LAS int* lbase = lcnt + 32;
    const int w = F.wave, r = F.lane & 31, hh = F.lane >> 5;
    float bw[128];
#pragma unroll
    for (int j = 0; j < 32; ++j)
#pragma unroll
        for (int i = 0; i < 4; ++i) bw[j * 4 + i] = WR[(size_t)(256 * w + 8 * j + 4 * hh + i) * 32 + r];
    if (F.tid < 32) lcnt[F.tid] = 0;
    __syncthreads();
    for (int tile = F.vcu; tile < T / 32; tile += F.G) {
        const int tok0 = tile * 32;
        const float* xr = H1 + (size_t)(tok0 + r) * DM + 256 * w + 4 * hh;
        f32x16 acc = {}; float ssq = 0.f;
#pragma unroll
        for (int jb = 0; jb < 4; ++jb) { f32x4 av[8];
#pragma unroll
            for (int jj = 0; jj < 8; ++jj) av[jj] = *(const f32x4*)(xr + 8 * (8 * jb + jj));
#pragma unroll
            for (int jj = 0; jj < 8; ++jj)
#pragma unroll
                for (int i = 0; i < 4; ++i) { acc = __builtin_amdgcn_mfma_f32_32x32x2f32(av[jj][i], bw[(8 * jb + jj) * 4 + i], acc, 0, 0, 0); ssq += av[jj][i] * av[jj][i]; } }
#pragma unroll
        for (int q = 0; q < 16; ++q) part[(w * 32 + ((q & 3) + 8 * (q >> 2) + 4 * hh)) * 33 + r] = acc[q];
        ssqp[(w * 2 + hh) * 32 + r] = ssq;
        __syncthreads();
        int my_e[2] = {0, 0}, my_rank[2] = {0, 0}; float my_g[2] = {0.f, 0.f}, my_rs[2] = {0.f, 0.f};
#pragma unroll
        for (int ps = 0; ps < 2; ++ps) {
            const int tl = 4 * w + 2 * ps + hh;
            float s = 0.f, lg = 0.f;
#pragma unroll
            for (int ww = 0; ww < 8; ++ww) { lg += part[(ww * 32 + tl) * 33 + r]; s += ssqp[(ww * 2 + 0) * 32 + tl] + ssqp[(ww * 2 + 1) * 32 + tl]; }
            const float rs = 1.f / sqrtf(s * (1.f / DM) + EPS);
            lg = lg * rs + b_router[r];
            float tv[4]; int ti[4]; float cur = lg;
#pragma unroll
            for (int k = 0; k < 4; ++k) { float bv = cur; int bi = r;
#pragma unroll
                for (int o = 1; o < 32; o <<= 1) { const float ov = __shfl_xor(bv, o); const int oi = __shfl_xor(bi, o); if (ov > bv || (ov == bv && oi < bi)) { bv = ov; bi = oi; } }
                tv[k] = bv; ti[k] = bi; if (r == bi) cur = -__builtin_inff(); }
            const float e1 = __expf(tv[1] - tv[0]), e2 = __expf(tv[2] - tv[0]), e3 = __expf(tv[3] - tv[0]); const float inv = 1.f / (1.f + e1 + e2 + e3);
            if (r < 4) { my_e[ps] = ti[r]; my_g[ps] = (r == 0 ? 1.f : r == 1 ? e1 : r == 2 ? e2 : e3) * inv; my_rs[ps] = rs;
                my_rank[ps] = __hip_atomic_fetch_add(lcnt + ti[r], 1, __ATOMIC_RELAXED, __HIP_MEMORY_SCOPE_WORKGROUP); }
        }
        __syncthreads();
        if (F.tid < 32) { const int n = lcnt[F.tid]; lbase[F.tid] = n ? (int)__hip_atomic_fetch_add(cnt + 64 * F.tid, (unsigned)n, RLX_AGENT) : 0; lcnt[F.tid] = 0; }
        __syncthreads();
        if (r < 4) {
#pragma unroll
            for (int ps = 0; ps < 2; ++ps) { const int t = tok0 + 4 * w + 2 * ps + hh, e = my_e[ps], pos = lbase[e] + my_rank[ps];
                RE[t * 4 + r] = e; RP[t * 4 + r] = pos; RG[t * 4 + r] = my_g[ps];
                LIST[(size_t)e * LIST_CAP + pos] = t; LISTR[(size_t)e * LIST_CAP + pos] = my_rs[ps]; }
        }
        __syncthreads();
    }
}

__device__ __forceinline__ void moe_tables(Frame& F) {
    LAS int* tstart = (LAS int*)(F.lds + TAB_OFF);
    if (F.tid < 64) {
        const int e = F.tid & 31; const int n = (int)__hip_atomic_load(F.ctl + CW_CNT + 64 * e, RLX_AGENT); const int tiles = (n + 255) >> 8;
        int incl = tiles;
#pragma unroll
        for (int o = 1; o < 32; o <<= 1) { const int v = __shfl_up(incl, o, 32); if (e >= o) incl += v; }
        if (F.tid < 32) { tstart[e] = incl - tiles; tstart[40 + e] = n; if (e == NE - 1) tstart[NE] = incl; } }
    __syncthreads();
}

__device__ __forceinline__ void p9_final(Frame& F, const Args& a) {
    const LAS int* tstart = (const LAS int*)(F.lds + TAB_OFF);
    const int* RE = (const int*)(F.ws + WS_RE); const int* RP = (const int*)(F.ws + WS_RP); const float* RG = (const float*)(F.ws + WS_RG);
    const unsigned char* YK = F.ws + WS_YK; const float* g_final = a.in[18]; float* out = a.out;
    const int gw = F.vcu * NWAVES + F.wave, NGW = F.G * NWAVES;
    f32x4 gf[8];
#pragma unroll
    for (int j = 0; j < 4; ++j) { gf[2 * j] = *((const GAS f32x4*)g_final + (64 * j + F.lane) * 2); gf[2 * j + 1] = *((const GAS f32x4*)g_final + (64 * j + F.lane) * 2 + 1); }
    i32x4 e4 = {0, 0, 0, 0}, p4 = {0, 0, 0, 0}; f32x4 g4 = {0.f, 0.f, 0.f, 0.f};
    if (gw < T) { e4 = ((const i32x4*)RE)[gw]; p4 = ((const i32x4*)RP)[gw]; g4 = ((const f32x4*)RG)[gw]; }
    for (int m = gw; m < T; m += NGW) {
        const GAS u32x2* yp[4];
#pragma unroll
        for (int k = 0; k < 4; ++k) yp[k] = (const GAS u32x2*)(YK + (size_t)(tstart[e4[k]] * 256 + p4[k]) * DM) + F.lane;
        GAS f32x4* xr = (GAS f32x4*)(out + (size_t)m * DM);
        f32x4 y[8]; u32x2 wv[4][4];
#pragma unroll
        for (int j = 0; j < 4; ++j) { y[2 * j] = xr[(64 * j + F.lane) * 2]; y[2 * j + 1] = xr[(64 * j + F.lane) * 2 + 1];
#pragma unroll
            for (int k = 0; k < 4; ++k) wv[j][k] = yp[k][64 * j]; }
        const f32x4 gk = g4;
        { const int mn = m + NGW; if (mn < T) { e4 = ((const i32x4*)RE)[mn]; p4 = ((const i32x4*)RP)[mn]; g4 = ((const f32x4*)RG)[mn]; } }
        float s = 0.f;
#pragma unroll
        for (int j = 0; j < 4; ++j) { f32x4 a0 = y[2 * j], a1 = y[2 * j + 1];
#pragma unroll
            for (int k = 0; k < 4; ++k) { const u32x2 w = wv[j][k];
                const f32x2 c0 = __builtin_amdgcn_cvt_pk_f32_fp8(w.x, false), c1 = __builtin_amdgcn_cvt_pk_f32_fp8(w.x, true), c2 = __builtin_amdgcn_cvt_pk_f32_fp8(w.y, false), c3 = __builtin_amdgcn_cvt_pk_f32_fp8(w.y, true);
                a0 += gk[k] * (f32x4){c0.x, c0.y, c1.x, c1.y}; a1 += gk[k] * (f32x4){c2.x, c2.y, c3.x, c3.y}; }
            y[2 * j] = a0; y[2 * j + 1] = a1;
            s += (a0.x * a0.x + a0.y * a0.y) + (a0.z * a0.z + a0.w * a0.w) + (a1.x * a1.x + a1.y * a1.y) + (a1.z * a1.z + a1.w * a1.w); }
        const float rstd = 1.f / sqrtf(wave_sum(s) * (1.f / DM) + EPS);
#pragma unroll
        for (int j = 0; j < 4; ++j) { xr[(64 * j + F.lane) * 2] = y[2 * j] * rstd * gf[2 * j]; xr[(64 * j + F.lane) * 2 + 1] = y[2 * j + 1] * rstd * gf[2 * j + 1]; }
    }
}
__device__ __forceinline__ void dbg_final_norm(Frame& F, const Args& a, const float* src) {
    const float* g_final = a.in[18]; float* out = a.out; const int gw = F.vcu * NWAVES + F.wave, NGW = F.G * NWAVES;
    for (int m = gw; m < T; m += NGW) {
        const GAS f32x4* xr = (const GAS f32x4*)(src + (size_t)m * DM) + F.lane; GAS f32x4* orow = (GAS f32x4*)(out + (size_t)m * DM) + F.lane;
        f32x4 v[8]; float s = 0.f;
#pragma unroll
        for (int j = 0; j < 8; ++j) { v[j] = xr[64 * j]; s += (v[j].x * v[j].x + v[j].y * v[j].y) + (v[j].z * v[j].z + v[j].w * v[j].w); }
        const float rstd = 1.f / sqrtf(wave_sum(s) * (1.f / DM) + EPS);
#pragma unroll
        for (int j = 0; j < 8; ++j) orow[64 * j] = v[j] * rstd * *((const GAS f32x4*)g_final + 64 * j + F.lane);
    }
}

__global__ void __launch_bounds__(NWAVES * 64, 2) mk_fwd(Args args) {
    extern __shared__ __attribute__((aligned(16))) unsigned char lds[];
    Frame F;
    F.lds = (LAS unsigned char*)lds; F.MISC = (volatile LAS unsigned*)(F.lds + MISC_OFF);
    F.tid = threadIdx.x; F.lane = F.tid & 63; F.wave = __builtin_amdgcn_readfirstlane(F.tid >> 6);
    F.G = gridDim.x; { const int bx = blockIdx.x; F.vcu = (F.G % 8 == 0) ? (bx % 8) * (F.G / 8) + bx / 8 : bx; }
    F.ws = args.ws; F.ctl = (gu32*)(args.ws + WS_CTL);
    for (int u = F.tid; u < (LDS_BYTES - LDSCTL_OFF) / 4; u += NWAVES * 64) ((LAS unsigned*)(F.lds + LDSCTL_OFF))[u] = 0u;
    __syncthreads();
    XcdBarrier bar; bar.bar = (unsigned*)(F.ctl + CW_BAR); bar.x = 0; bar.st = nullptr;
#if MK_ONE_LAUNCH
    bar = xcd_barrier_post((unsigned*)(F.ctl + CW_BAR), F.MISC + 8);
#define GRID_BAR() xcd_barrier(bar)
#else
#define GRID_BAR() do { } while (0)
#endif
    const int lo = args.ph_lo, hi = args.ph_hi;
#ifndef MK_PHASE_MASK
#define MK_PHASE_MASK 0xffffffffu
#endif
#define IN(k) (((MK_PHASE_MASK >> (k)) & 1u) && lo <= (k) && (k) < hi)
#define BOTH(k) (IN(k) && IN((k) + 1))
    unsigned char* ws = args.ws;
    bf16_t* PROJ = (bf16_t*)(ws + WS_PROJ); float* ssq = (float*)(ws + WS_SSQ); const f32x2* rope = (const f32x2*)(ws + WS_ROPE);
    LAS int* tstart = (LAS int*)(F.lds + TAB_OFF);

#ifdef MK_TPROBE
#define STAMP(k) do { if (blockIdx.x == 0 && F.tid == 0) ((unsigned long long*)(ws + 21 * MiB))[k] = __builtin_amdgcn_s_memrealtime(); } while (0)
#else
#define STAMP(k) do { } while (0)
#endif
    STAMP(0);
    if (IN(0)) { p0_prologue(F, args); if (MK_DUP == 0) { GRID_BAR(); p0_prologue(F, args); } if (BOTH(0)) GRID_BAR(); }
    STAMP(1);
    if (IN(1)) {
        pg8::DenseSched S; S.o.init(T / 256, 17, F.G, (int)blockIdx.x); S.A = ws + WS_HN; S.Bt = ws + WS_WIN; S.lda = DM * (FP8D ? 1 : 2); S.ldb = S.lda;
        EpiP1 E{PROJ, (bf16_t*)(ws + WS_KR8), (float*)(ws + WS_FL), ssq, rope, (float*)(ws + WS_NRMP)};
        pg8::gemm_phase<EpiP1, pg8::DenseSched, false, FP8D>(F.lds, S.lda, S, E);
        if (MK_DUP == 1) { GRID_BAR(); pg8::gemm_phase<EpiP1, pg8::DenseSched, false, FP8D>(F.lds, S.lda, S, E); }
        if (BOTH(1)) GRID_BAR();
    }
    STAMP(2);
    if (IN(2)) {
        p2_cumsum(F, args); p2_norms(F); __syncthreads();
        { pg8::DenseSched S; S.o.init(T / 256, QW / 256, F.G, (int)blockIdx.x); S.A = PROJ; S.Bt = ws + WS_WQB; S.lda = PW * 2; S.ldb = 1024;
          EpiQ E{(bf16_t*)(ws + WS_QB), ssq, rope};
          pg8::gemm_phase<EpiQ, pg8::DenseSched, false>(F.lds, 1024, S, E); }
        { pg8::DenseSched S; S.o.init(T / 256, KVW / 256, F.G, (int)blockIdx.x); S.A = PROJ + 512; S.Bt = ws + WS_WKVB; S.lda = PW * 2; S.ldb = 1024;
          EpiKV E{(bf16_t*)(ws + WS_KV), ssq + (size_t)T * 8, ws + WS_K8};
          pg8::gemm_phase<EpiKV, pg8::DenseSched, false>(F.lds, 1024, S, E); }
        if (BOTH(2)) GRID_BAR();
    }
    STAMP(3);
    if (IN(3)) {
        const bf16_t* KV = (const bf16_t*)(ws + WS_KV); bf16_t* O = (bf16_t*)(ws + WS_O);
#define P3_BODY() do { \
        attn_group<192, false, QW, KVW, KVW>(F, (char*)lds, (const bf16_t*)(ws + WS_QB), 192, (const bf16_t*)(ws + WS_K8), KV + 128, 256, (const bf16_t*)(ws + WS_KR8), nullptr, O, 0); \
        attn_group<128, true, PW, PW, PW>(F, (char*)lds, PROJ + 1024, 128, PROJ + 2048, PROJ + 3072, 128, nullptr, (const float*)(ws + WS_CUM), O + 1024, 8); } while (0)
        P3_BODY();
        if (MK_DUP == 3) { GRID_BAR(); P3_BODY(); }
        if (MK_DUP == 31) { GRID_BAR(); attn_group<192, false, QW, KVW, KVW>(F, (char*)lds, (const bf16_t*)(ws + WS_QB), 192, (const bf16_t*)(ws + WS_K8), KV + 128, 256, (const bf16_t*)(ws + WS_KR8), nullptr, O, 0); }
        if (MK_DUP == 32) { GRID_BAR(); attn_group<128, true, PW, PW, PW>(F, (char*)lds, PROJ + 1024, 128, PROJ + 2048, PROJ + 3072, 128, nullptr, (const float*)(ws + WS_CUM), O + 1024, 8); }
        if (BOTH(3)) GRID_BAR();
    }
    STAMP(4);
    { int t_ = threadIdx.x; asm volatile("" : "+v"(t_)); F.tid = t_; F.lane = t_ & 63; }
    STAMP(5);
    if (IN(5)) {
        pg8::DenseSched S; S.o.init(T / 256, DM / 256, F.G, (int)blockIdx.x); S.A = FP8O ? ws + WS_HN : ws + WS_O; S.Bt = ws + WS_WO; S.lda = DM * (FP8O ? 1 : 2); S.ldb = S.lda;
        EpiWo E{args.in[0], args.out, ws + WS_XB, (const float*)(ws + WS_RR)};
        { pg8::Unit u0;
          for (int i = 0; i < 64; i += 2) { const int ii = i + (F.tid >> 8); if (!S.next(i, u0)) break; pg8::Unit u1; if (S.next(ii, u1)) onorm_tile(F, u1.pm, F.tid & 255); }
          asm volatile("s_waitcnt vmcnt(0)" ::: "memory"); __syncthreads(); }
        pg8::gemm_phase<EpiWo, pg8::DenseSched, false, FP8O>(F.lds, S.lda, S, E);
        if (MK_DUP == 5) { GRID_BAR(); pg8::gemm_phase<EpiWo, pg8::DenseSched, false, FP8O>(F.lds, S.lda, S, E); }
        if (BOTH(5)) GRID_BAR();
    }
    STAMP(6);
    if (IN(6)) { p6_router(F, args); if (BOTH(6)) GRID_BAR(); }
    STAMP(7);
    if (IN(7)) {
        moe_tables(F);
        pg8::MoeSched S; S.o.init(tstart[NE], 16, F.G, (int)blockIdx.x); S.A = ws + WS_XB; S.Bt = ws + WS_WGU; S.lda = DM * (USE_FP8 ? 1 : 2); S.ldb = S.lda; S.nBrows = 4096;
        S.tstart = tstart; S.list = (const int*)(ws + WS_LIST); S.cnt = F.ctl + CW_CNT; S.gather = true;
        EpiGU E{ws + WS_H, args.in[15], (const float*)(ws + WS_LISTR), tstart};
        pg8::gemm_phase<EpiGU, pg8::MoeSched, true, USE_FP8>(F.lds, S.lda, S, E);
        if (MK_DUP == 7) { GRID_BAR(); pg8::gemm_phase<EpiGU, pg8::MoeSched, true, USE_FP8>(F.lds, S.lda, S, E); }
        if (BOTH(7)) GRID_BAR();
    }
    STAMP(8);
    if (IN(8)) {
        if (!IN(7)) moe_tables(F);
        pg8::MoeSched S; S.o.init(tstart[NE], 8, F.G, (int)blockIdx.x); S.A = ws + WS_H; S.Bt = ws + WS_WDN; S.lda = DM * (USE_FP8 ? 1 : 2); S.ldb = S.lda; S.nBrows = DM;
        S.tstart = tstart; S.list = (const int*)(ws + WS_LIST); S.cnt = F.ctl + CW_CNT; S.gather = false;
        EpiDn E{ws + WS_YK, args.in[17]};
        pg8::gemm_phase<EpiDn, pg8::MoeSched, false, USE_FP8>(F.lds, S.lda, S, E);
        if (MK_DUP == 8) { GRID_BAR(); pg8::gemm_phase<EpiDn, pg8::MoeSched, false, USE_FP8>(F.lds, S.lda, S, E); }
        if (BOTH(8)) GRID_BAR();
    }
    STAMP(9);
#ifdef MK_TPROBE
    GRID_BAR();
#endif
    if (IN(9)) { if (!IN(7)) moe_tables(F); p9_final(F, args); }
    if (IN(20)) dbg_final_norm(F, args, args.in[0]);
    if (IN(21)) dbg_final_norm(F, args, args.out);
#undef IN
#undef BOTH
}

extern "C" void kernel_launch(void* const* d_in, const int* in_sizes, int n_in, void* d_out, int out_size, void* d_ws, size_t ws_size, hipStream_t stream) {
    static int grid = 0;
    if (grid == 0) {
        if (n_in != 19 || in_sizes[0] != T * DM || out_size != T * DM || ws_size < WS_END) {
            fprintf(stderr, "kernel_launch: unexpected shapes (n_in %d, in0 %d, out %d, ws %zu < %zu); nothing launched\n", n_in, n_in > 0 ? in_sizes[0] : -1, out_size, ws_size, (size_t)WS_END); grid = -1; return; }
        int dev = 0, cus = 0, per_cu = 0;
        if (hipGetDevice(&dev) != hipSuccess || hipDeviceGetAttribute(&cus, hipDeviceAttributeMultiprocessorCount, dev) != hipSuccess) { grid = -1; return; }
        if (hipFuncSetAttribute((const void*)mk_fwd, hipFuncAttributeMaxDynamicSharedMemorySize, LDS_BYTES) != hipSuccess) { fprintf(stderr, "kernel_launch: hipFuncSetAttribute failed\n"); grid = -1; return; }
        if (hipOccupancyMaxActiveBlocksPerMultiprocessor(&per_cu, (const void*)mk_fwd, NWAVES * 64, LDS_BYTES) != hipSuccess || per_cu < 1)
            fprintf(stderr, "kernel_launch: note: occupancy query reports %d workgroups per CU\n", per_cu);
        (void)hipGetLastError();
        grid = cus;
    }
    if (grid < 0) return;
    if (hipMemsetAsync((char*)d_ws + WS_CTL, 0, CTL_ZERO_BYTES, stream) != hipSuccess) return;
    Args a{};
    for (int i = 0; i < 19; ++i) a.in[i] = (const float*)d_in[i];
    a.out = (float*)d_out; a.ws = (unsigned char*)d_ws;
#if MK_ONE_LAUNCH
    a.ph_lo = 0; a.ph_hi = MK_PH_END;
    hipLaunchKernelGGL(mk_fwd, dim3(grid), dim3(NWAVES * 64), LDS_BYTES, stream, a);
#else
    for (int p = 0; p < MK_PH_END; ++p) { a.ph_lo = p; a.ph_hi = p + 1; hipLaunchKernelGGL(mk_fwd, dim3(grid), dim3(NWAVES * 64), LDS_BYTES, stream, a); }
#endif
#ifdef MK_DBG_PHASE
    a.ph_lo = MK_DBG_PHASE; a.ph_hi = MK_DBG_PHASE + 1; hipLaunchKernelGGL(mk_fwd, dim3(grid), dim3(NWAVES * 64), LDS_BYTES, stream, a);
#endif
}
```
